# Optimizing an MI355X kernel written in HIP

```python
import math
import jax, jax.numpy as jnp
from jax import lax
import numpy as np

D_MODEL = 1024
BATCH = 8
SEQ = 4096
DEPTH = 2

CHUNK = 64
D_MIX = D_MODEL
HEAD_DIM = 64
GROUP_W = D_MIX // 4
A_GROUPS = GROUP_W // HEAD_DIM
A_BLOCK = 128
B_HEADS = GROUP_W // HEAD_DIM
B_PREV_CHUNKS = 8
B_BAND = (B_PREV_CHUNKS + 1) * CHUNK
REL_CLIP = 128
C_HEADS = GROUP_W // HEAD_DIM
IDX_HEADS = 8
IDX_DIM = 64
TOPK_MAX = 256
Q_BLOCK = 128
T5_BUCKETS = 32
T5_MAX_DIST = 128
N_MEM = 256
M_HEADS = GROUP_W // HEAD_DIM
DEEPNORM_ALPHA = (2 * DEPTH) ** 0.25
DEEPNORM_BETA = (8 * DEPTH) ** -0.25
LN_EPS = 1e-5
SPLITS = (GROUP_W, GROUP_W, GROUP_W,
          GROUP_W, GROUP_W, GROUP_W, GROUP_W,
          GROUP_W, GROUP_W, GROUP_W, GROUP_W,
          IDX_HEADS * IDX_DIM, IDX_DIM, IDX_HEADS,
          GROUP_W, GROUP_W)
D_IN = sum(SPLITS)

kernel_name = "hybrid_streaming_gmlp_band_dsa_mem"


def layer_norm(x, g, b):
    xf = x.astype(jnp.float32)
    mu = jnp.mean(xf, axis=-1, keepdims=True)
    var = jnp.mean(jnp.square(xf - mu), axis=-1, keepdims=True)
    y = (xf - mu) * lax.rsqrt(var + LN_EPS)
    return (y * g.astype(jnp.float32) + b.astype(jnp.float32)).astype(x.dtype)


def softmax_f32(s, dtype):
    return jax.nn.softmax(s.astype(jnp.float32), axis=-1).astype(dtype)


def spatial_gating(u, v, ln_g, ln_b, w_s, b_s):
    bsz, seq, _ = v.shape
    nb = seq // A_BLOCK
    v = layer_norm(v, ln_g, ln_b)
    cpos = jnp.arange(A_BLOCK) // CHUNK
    mask = cpos[None, :] <= cpos[:, None]
    w = jnp.where(mask[None], w_s, 0.0).astype(v.dtype)
    vb = v.reshape(bsz, nb, A_BLOCK, A_GROUPS, HEAD_DIM)
    mixed = jnp.einsum('gij,bnjgc->bnigc', w, vb) + b_s.T.astype(v.dtype)[None, None, :, :, None]
    return u * mixed.reshape(bsz, seq, GROUP_W)


def chunk_band_attention(q, k, v, rel_bias):
    bsz, seq, h, dh = q.shape
    nc = seq // CHUNK
    qc = q.reshape(bsz, nc, CHUNK, h, dh)
    pad = ((0, 0), (B_PREV_CHUNKS, 0), (0, 0), (0, 0), (0, 0))
    kp = jnp.pad(k.reshape(bsz, nc, CHUNK, h, dh), pad)
    vp = jnp.pad(v.reshape(bsz, nc, CHUNK, h, dh), pad)
    kb = jnp.concatenate([kp[:, o:o + nc] for o in range(B_PREV_CHUNKS + 1)], axis=2)
    vb = jnp.concatenate([vp[:, o:o + nc] for o in range(B_PREV_CHUNKS + 1)], axis=2)
    s = jnp.einsum('bcqhd,bckhd->bchqk', qc, kb).astype(jnp.float32) * (dh ** -0.5)
    qi = jnp.arange(CHUNK)
    kk = jnp.arange(B_BAND)
    rel = qi[:, None] + B_PREV_CHUNKS * CHUNK - kk[None, :]
    rel_idx = jnp.clip(rel, -REL_CLIP, REL_CLIP) + REL_CLIP
    bias = rel_bias[:, rel_idx].astype(jnp.float32)
    key_chunk = jnp.arange(nc)[:, None] - B_PREV_CHUNKS + kk[None, :] // CHUNK
    valid = key_chunk >= 0
    s = jnp.where(valid[None, :, None, None, :], s + bias[None, None], -jnp.inf)
    p = softmax_f32(s, v.dtype)
    o = jnp.einsum('bchqk,bckhd->bcqhd', p, vb)
    return o.reshape(bsz, seq, h * dh)


def t5_bucket(rel):
    nb = T5_BUCKETS // 2
    max_exact = nb // 2
    ret = jnp.where(rel > 0, nb, 0)
    n = jnp.abs(rel)
    nf = jnp.maximum(n, 1).astype(jnp.float32)
    large = max_exact + (jnp.log(nf / max_exact) / math.log(T5_MAX_DIST / max_exact)
                         * (nb - max_exact)).astype(jnp.int32)
    large = jnp.minimum(large, nb - 1)
    return ret + jnp.where(n < max_exact, n, large)


def dsa_attention(q, k, v, iq, ik, iw, t5_table):
    bsz, seq, h, dh = q.shape
    k_sel = min(TOPK_MAX, seq // 4)
    nqb = seq // Q_BLOCK

    def to_blocks(a):
        return jnp.moveaxis(a.reshape((bsz, nqb, Q_BLOCK) + a.shape[2:]), 1, 0)

    key_chunk = jnp.arange(seq) // CHUNK
    ikf = ik.astype(jnp.float32)

    def block(args):
        qb, iqb, iwb, qpos = args
        qchunk = qpos // CHUNK
        logits = jnp.einsum('bqhd,bsd->bqhs', iqb.astype(jnp.float32), ikf) * (IDX_DIM ** -0.5)
        score = jnp.einsum('bqhs,bqh->bqs', jax.nn.relu(logits),
                           iwb.astype(jnp.float32) * (IDX_HEADS ** -0.5))
        admissible = key_chunk[None, :] <= qchunk[:, None]
        score = jnp.where(admissible[None], score, -jnp.inf)
        _, idx = lax.top_k(score, k_sel)
        kg = jax.vmap(lambda kk, ii: kk[ii])(k, idx)
        vg = jax.vmap(lambda vv, ii: vv[ii])(v, idx)
        s = jnp.einsum('bqhd,bqkhd->bqhk', qb, kg).astype(jnp.float32) * (dh ** -0.5)
        bias = t5_table[t5_bucket(idx - qpos[None, :, None])]
        s = s + jnp.moveaxis(bias, -1, 2).astype(jnp.float32)
        valid = (idx // CHUNK) <= qchunk[None, :, None]
        s = jnp.where(valid[:, :, None, :], s, -jnp.inf)
        p = softmax_f32(s, v.dtype)
        return jnp.einsum('bqhk,bqkhd->bqhd', p, vg)

    out = lax.map(block, (to_blocks(q), to_blocks(iq), to_blocks(iw),
                          jnp.arange(seq).reshape(nqb, Q_BLOCK)))
    return jnp.moveaxis(out, 0, 1).reshape(bsz, seq, h * dh)


def memory_attention(q, km, vm):
    bsz, seq, h, dh = q.shape
    s = jnp.einsum('bshd,bmhd->bhsm', q, km).astype(jnp.float32) * (dh ** -0.5)
    p = softmax_f32(s, vm.dtype)
    return jnp.einsum('bhsm,bmhd->bshd', p, vm).reshape(bsz, seq, h * dh)


def hybrid_layer(x, mem, w_in, b_in, a_ln_g, a_ln_b, a_ws, a_bs, b_rel, t5_table,
                 w_mem_kv, w_out, b_out, ln_g, ln_b):
    bsz, seq, _ = x.shape
    n_mem = mem.shape[1]
    proj = x @ w_in + b_in
    split_points = np.cumsum(SPLITS)[:-1].tolist()
    (a_u, a_v, a_g, bq, bk, bv, bg, cq, ck, cv, cg,
     iq, ik, iw, mq, mg) = jnp.split(proj, split_points, axis=-1)

    def heads(t):
        return t.reshape(t.shape[0], t.shape[1], -1, HEAD_DIM)

    ya = spatial_gating(jax.nn.gelu(a_u), jax.nn.gelu(a_v), a_ln_g, a_ln_b, a_ws, a_bs)
    yb = chunk_band_attention(heads(bq), heads(bk), heads(bv), b_rel)
    yc = dsa_attention(heads(cq), heads(ck), heads(cv),
                       iq.reshape(bsz, seq, IDX_HEADS, IDX_DIM), ik, iw, t5_table)
    km, vm = jnp.split(mem @ w_mem_kv, 2, axis=-1)
    ym = memory_attention(heads(mq), km.reshape(bsz, n_mem, M_HEADS, HEAD_DIM),
                          vm.reshape(bsz, n_mem, M_HEADS, HEAD_DIM))
    mixed = jnp.concatenate([ya * jax.nn.silu(a_g), yb * jax.nn.silu(bg),
                             yc * jax.nn.silu(cg), ym * jax.nn.silu(mg)], axis=-1)
    y = mixed @ w_out + b_out
    return layer_norm(DEEPNORM_ALPHA * x + y, ln_g, ln_b)


def setup_inputs(seed: int = 0) -> dict:
    key = jax.random.key(seed)
    ks = jax.random.split(key, 17)
    f32 = jnp.float32

    def nrm(k, shape, scale):
        return jax.random.normal(k, shape, f32) * scale

    return {
        "x": nrm(ks[0], (BATCH, SEQ, D_MODEL), 1.0),
        "mem": nrm(ks[1], (BATCH, N_MEM, D_MODEL), 1.0),
        "ln_in_g": 1.0 + nrm(ks[2], (D_MODEL,), 0.02),
        "ln_in_b": nrm(ks[3], (D_MODEL,), 0.02),
        "w_in": nrm(ks[4], (DEPTH, D_MODEL, D_IN), D_MODEL ** -0.5),
        "b_in": nrm(ks[5], (DEPTH, D_IN), 0.02),
        "a_ln_g": 1.0 + nrm(ks[6], (DEPTH, GROUP_W), 0.02),
        "a_ln_b": nrm(ks[7], (DEPTH, GROUP_W), 0.02),
        "a_ws": nrm(ks[8], (DEPTH, A_GROUPS, A_BLOCK, A_BLOCK), A_BLOCK ** -0.5),
        "a_bs": 1.0 + nrm(ks[9], (DEPTH, A_GROUPS, A_BLOCK), 0.02),
        "b_rel": nrm(ks[10], (DEPTH, B_HEADS, 2 * REL_CLIP + 1), 0.1),
        "t5_table": nrm(ks[11], (T5_BUCKETS, C_HEADS), 0.1),
        "w_mem_kv": nrm(ks[12], (DEPTH, D_MODEL, 2 * GROUP_W), D_MODEL ** -0.5),
        "w_out": nrm(ks[13], (DEPTH, D_MIX, D_MODEL), D_MIX ** -0.5 * DEEPNORM_BETA),
        "b_out": nrm(ks[14], (DEPTH, D_MODEL), 0.02),
        "ln_g": 1.0 + nrm(ks[15], (DEPTH, D_MODEL), 0.02),
        "ln_b": nrm(ks[16], (DEPTH, D_MODEL), 0.02),
    }


def reference(x, mem, ln_in_g, ln_in_b, w_in, b_in, a_ln_g, a_ln_b, a_ws, a_bs, b_rel,
              t5_table, w_mem_kv, w_out, b_out, ln_g, ln_b):
    h = layer_norm(x, ln_in_g, ln_in_b)
    for l in range(DEPTH):
        h = hybrid_layer(h, mem, w_in[l], b_in[l], a_ln_g[l], a_ln_b[l], a_ws[l], a_bs[l],
                         b_rel[l], t5_table, w_mem_kv[l], w_out[l], b_out[l], ln_g[l], ln_b[l])
    return h
```

```cpp
#include <hip/hip_runtime.h>
#include <cstdio>
#include <cstdint>

namespace nv {
typedef unsigned short bf16;
constexpr int NB = 8, S = 4096, D = 1024, T = NB * S, GW = 256, DIN = 3912, NMEM = 256;
constexpr float LN_EPS = 1e-5f;
constexpr float ALPHA = 1.41421356237309515f;
constexpr size_t MiB = 1u << 20;
constexpr size_t WS_TBL = 22 * MiB;
constexpr size_t WS_KM = 24 * MiB;
constexpr size_t WS_VM = 26 * MiB;
constexpr size_t WS_HB = 32 * MiB;
constexpr size_t WS_MIX = 96 * MiB;
constexpr size_t WS_P13 = 160 * MiB;
constexpr size_t WS_IQ = 368 * MiB;
constexpr size_t WS_IK = 400 * MiB;
constexpr size_t WS_IW = 404 * MiB;
constexpr size_t WS_BM = 406 * MiB;
constexpr size_t WS_END = 422 * MiB;
enum Grp { G_AU = 0, G_AV, G_AG, G_BQ, G_BK, G_BV, G_BG, G_CQ, G_CK, G_CV, G_CG, G_MQ, G_MG };

__device__ __forceinline__ float bf2f(bf16 v) { return __uint_as_float((unsigned)v << 16); }
__device__ __forceinline__ bf16 f2bf(float f) { unsigned u = __float_as_uint(f); return (bf16)((u + 0x7fffu + ((u >> 16) & 1u)) >> 16); }
__device__ __forceinline__ float gelu_tanh(float x) { const float u = 0.7978845608028654f * (x + 0.044715f * x * x * x); return 0.5f * x * (1.f + tanhf(u)); }
__device__ __forceinline__ float silu(float x) { return x / (1.f + __expf(-x)); }
__device__ __forceinline__ float wave_sum(float v) {
#pragma unroll
    for (int o = 1; o < 64; o <<= 1) v += __shfl_xor(v, o);
    return v;
}
__device__ __forceinline__ float wave_max(float v) {
#pragma unroll
    for (int o = 1; o < 64; o <<= 1) v = fmaxf(v, __shfl_xor(v, o));
    return v;
}

__global__ void __launch_bounds__(256) k_ln_rows(const float* in, float* out, bf16* outb, const float* g, const float* b, int rows) {
    const int wave = threadIdx.x >> 6, lane = threadIdx.x & 63;
    const int row = blockIdx.x * 4 + wave; if (row >= rows) return;
    const float4* xr = (const float4*)(in + (size_t)row * D) + lane;
    float4 v[4]; float s = 0.f;
#pragma unroll
    for (int j = 0; j < 4; ++j) { v[j] = xr[64 * j]; s += (v[j].x + v[j].y) + (v[j].z + v[j].w); }
    const float mean = wave_sum(s) * (1.f / D); float s2 = 0.f;
#pragma unroll
    for (int j = 0; j < 4; ++j) { v[j].x -= mean; v[j].y -= mean; v[j].z -= mean; v[j].w -= mean; s2 += (v[j].x * v[j].x + v[j].y * v[j].y) + (v[j].z * v[j].z + v[j].w * v[j].w); }
    const float rstd = rsqrtf(wave_sum(s2) * (1.f / D) + LN_EPS);
#pragma unroll
    for (int j = 0; j < 4; ++j) {
        const int c = 4 * (lane + 64 * j);
        const float4 gg = *(const float4*)(g + c), bb = *(const float4*)(b + c);
        float4 o; o.x = v[j].x * rstd * gg.x + bb.x; o.y = v[j].y * rstd * gg.y + bb.y; o.z = v[j].z * rstd * gg.z + bb.z; o.w = v[j].w * rstd * gg.w + bb.w;
        *(float4*)(out + (size_t)row * D + c) = o;
        if (outb) { bf16* ob = outb + (size_t)row * D + c; ob[0] = f2bf(o.x); ob[1] = f2bf(o.y); ob[2] = f2bf(o.z); ob[3] = f2bf(o.w); }
    }
}

struct Route { bf16* p13; bf16* iq; bf16* ik; float* iw; float* outf; bf16* km; bf16* vm; };
__device__ __forceinline__ void route_in(const Route& R, int row, int col, float v) {
    if (col < 2816) {
        const int grp = col >> 8, cc = col & 255;
        if (grp == G_AU || grp == G_AV) v = gelu_tanh(v);
        else if (grp == G_AG || grp == G_BG || grp == G_CG) v = silu(v);
        else if (grp == G_BQ || grp == G_CQ) v *= 0.125f;
        R.p13[(size_t)grp * T * GW + (size_t)row * GW + cc] = f2bf(v);
    } else if (col < 3328) R.iq[(size_t)row * 512 + (col - 2816)] = f2bf(v);
    else if (col < 3392) R.ik[(size_t)row * 64 + (col - 3328)] = f2bf(v);
    else if (col < 3400) R.iw[(size_t)row * 8 + (col - 3392)] = v;
    else if (col < 3656) R.p13[(size_t)G_MQ * T * GW + (size_t)row * GW + (col - 3400)] = f2bf(v * 0.125f);
    else R.p13[(size_t)G_MG * T * GW + (size_t)row * GW + (col - 3656)] = f2bf(silu(v));
}

template <int MODE, typename AT>
__global__ void __launch_bounds__(256) k_gemm_naive(const AT* A, const float* W, const float* bias, int M, int N, int K, Route R) {
    __shared__ float As[16][64 + 1];
    __shared__ float Bs[16][64 + 1];
    const int tx = threadIdx.x & 15, ty = threadIdx.x >> 4;
    const int m0 = blockIdx.y * 64, n0 = blockIdx.x * 64;
    float acc[4][4];
#pragma unroll
    for (int i = 0; i < 4; ++i)
#pragma unroll
        for (int j = 0; j < 4; ++j) acc[i][j] = 0.f;
    for (int k0 = 0; k0 < K; k0 += 16) {
#pragma unroll
        for (int i = 0; i < 4; ++i) {
            const int e = threadIdx.x + 256 * i, r = e >> 4, kk = e & 15;
            float v;
            if constexpr (sizeof(AT) == 2) v = bf2f(((const bf16*)A)[(size_t)(m0 + r) * K + k0 + kk]);
            else v = ((const float*)A)[(size_t)(m0 + r) * K + k0 + kk];
            As[kk][r] = v;
        }
#pragma unroll
        for (int i = 0; i < 4; ++i) {
            const int e = threadIdx.x + 256 * i, kk = e >> 6, c = e & 63;
            Bs[kk][c] = (n0 + c < N) ? W[(size_t)(k0 + kk) * N + n0 + c] : 0.f;
        }
        __syncthreads();
#pragma unroll
        for (int kk = 0; kk < 16; ++kk) {
            float a[4], b[4];
#pragma unroll
            for (int i = 0; i < 4; ++i) { a[i] = As[kk][ty * 4 + i]; b[i] = Bs[kk][tx * 4 + i]; }
#pragma unroll
            for (int i = 0; i < 4; ++i)
#pragma unroll
                for (int j = 0; j < 4; ++j) acc[i][j] += a[i] * b[j];
        }
        __syncthreads();
    }
#pragma unroll
    for (int i = 0; i < 4; ++i)
#pragma unroll
        for (int j = 0; j < 4; ++j) {
            const int row = m0 + ty * 4 + i, col = n0 + tx * 4 + j;
            if (col >= N) continue;
            const float v = acc[i][j] + (bias ? bias[col] : 0.f);
            if (MODE == 0) route_in(R, row, col, v);
            else if (MODE == 1) { float* o = R.outf + (size_t)row * D + col; *o = ALPHA * (*o) + v; }
            else { if (col < 256) R.km[(size_t)row * 256 + col] = f2bf(v); else R.vm[(size_t)row * 256 + col - 256] = f2bf(v); }
        }
}

__global__ void k_tables(const float* t5, float* tbl) {
    const int i = blockIdx.x * blockDim.x + threadIdx.x; if (i >= 4 * 257) return;
    const int h = i / 257, d = i % 257 - 128, rel = -d;
    const int n = rel < 0 ? -rel : rel;
    int bucket = rel > 0 ? 16 : 0;
    if (n < 8) bucket += n;
    else { int lg = 31 - __clz(n * n); int large = 8 + lg - 6; if (large > 15) large = 15; bucket += large; }
    tbl[i] = t5[bucket * 4 + h];
}

__global__ void __launch_bounds__(256) k_a_ln(bf16* av, const float* g, const float* b) {
    const int wave = threadIdx.x >> 6, lane = threadIdx.x & 63;
    const int row = blockIdx.x * 4 + wave;
    bf16* p = av + (size_t)row * GW + lane * 4;
    float v[4]; float s = 0.f;
#pragma unroll
    for (int j = 0; j < 4; ++j) { v[j] = bf2f(p[j]); s += v[j]; }
    const float mean = wave_sum(s) * (1.f / GW); float s2 = 0.f;
#pragma unroll
    for (int j = 0; j < 4; ++j) { v[j] -= mean; s2 += v[j] * v[j]; }
    const float rstd = rsqrtf(wave_sum(s2) * (1.f / GW) + LN_EPS);
#pragma unroll
    for (int j = 0; j < 4; ++j) p[j] = f2bf(v[j] * rstd * g[lane * 4 + j] + b[lane * 4 + j]);
}
__global__ void __launch_bounds__(256) k_a_mix(const bf16* au, const bf16* avn, const bf16* ag, const float* ws_, const float* bs, bf16* mix) {
    __shared__ float vt[128][64];
    const int blk = blockIdx.x, g = blockIdx.y, t = threadIdx.x;
    const size_t row0 = (size_t)blk * 128;
    for (int e = t; e < 128 * 64; e += 256) { const int j = e >> 6, c = e & 63; vt[j][c] = bf2f(avn[(row0 + j) * GW + g * 64 + c]); }
    __syncthreads();
    const int c = t & 63;
    for (int i = t >> 6; i < 128; i += 4) {
        const float* wr = ws_ + ((size_t)g * 128 + i) * 128;
        const int jmax = i < 64 ? 64 : 128;
        float acc = 0.f;
        for (int j = 0; j < jmax; ++j) acc += wr[j] * vt[j][c];
        acc += bs[g * 128 + i];
        const size_t idx = (row0 + i) * GW + g * 64 + c;
        mix[(row0 + i) * D + g * 64 + c] = f2bf(bf2f(au[idx]) * acc * bf2f(ag[idx]));
    }
}

template <int MODE>
__global__ void __launch_bounds__(128) k_attn_naive(const bf16* Q, const bf16* K, const bf16* V, const bf16* G, bf16* mix, int colofs, const float* tbl, const unsigned* bm) {
    __shared__ float sc[2][4096];
    __shared__ float qs[2][64];
    const int wave = threadIdx.x >> 6, lane = threadIdx.x & 63;
    const int gid = blockIdx.x * 2 + wave, token = gid >> 2, h = gid & 3;
    const int b = token / S, pos = token % S, c = pos >> 6;
    int k0, k1; size_t kbase;
    if (MODE == 0) { k0 = (c >= 8 ? c - 8 : 0) * 64; k1 = (c + 1) * 64; kbase = (size_t)b * S; }
    else if (MODE == 1) { k0 = 0; k1 = (c + 1) * 64; kbase = (size_t)b * S; }
    else { k0 = 0; k1 = NMEM; kbase = (size_t)b * NMEM; }
    qs[wave][lane] = bf2f(Q[(size_t)token * GW + h * 64 + lane]);
    __syncthreads();
    float mx = -INFINITY;
    for (int key = k0 + lane; key < k1; key += 64) {
        const bf16* kr = K + (kbase + key) * GW + h * 64;
        float s = 0.f;
#pragma unroll 8
        for (int d = 0; d < 64; ++d) s += qs[wave][d] * bf2f(kr[d]);
        if (MODE != 2) { int dd = pos - key; dd = dd < -128 ? -128 : (dd > 128 ? 128 : dd); s += tbl[h * 257 + dd + 128]; }
        if (MODE == 1) { const unsigned w = bm[(size_t)token * 128 + (key >> 5)]; if (!((w >> (key & 31)) & 1u)) s = -INFINITY; }
        sc[wave][key - k0] = s; mx = fmaxf(mx, s);
    }
    mx = wave_max(mx);
    float sum = 0.f;
    for (int key = k0 + lane; key < k1; key += 64) { const float p = __expf(sc[wave][key - k0] - mx); sc[wave][key - k0] = p; sum += p; }
    sum = wave_sum(sum);
    __syncthreads();
    float o = 0.f;
    for (int key = k0; key < k1; ++key) { const float p = sc[wave][key - k0]; if (p != 0.f) o += p * bf2f(V[(kbase + key) * GW + h * 64 + lane]); }
    o /= sum;
    mix[(size_t)token * D + colofs + h * 64 + lane] = f2bf(o * bf2f(G[(size_t)token * GW + h * 64 + lane]));
}

__device__ __forceinline__ int block_sum_i(int v, int* red) {
#pragma unroll
    for (int o = 1; o < 64; o <<= 1) v += __shfl_xor(v, o);
    __syncthreads();
    if ((threadIdx.x & 63) == 0) red[threadIdx.x >> 6] = v;
    __syncthreads();
    return red[0] + red[1] + red[2] + red[3];
}
__global__ void __launch_bounds__(256) k_c1_naive(const bf16* IQ, const bf16* IK, const float* IW, unsigned* bm) {
    __shared__ float qh[512];
    __shared__ unsigned keys[4096];
    __shared__ int red[4];
    __shared__ float wq[8];
    const int token = blockIdx.x, t = threadIdx.x;
    const int b = token / S, pos = token % S, c = pos >> 6, n = (c + 1) * 64;
    qh[t] = bf2f(IQ[(size_t)token * 512 + t]); qh[t + 256] = bf2f(IQ[(size_t)token * 512 + t + 256]);
    if (t < 8) wq[t] = IW[(size_t)token * 8 + t] * 0.35355339059327373f;
    __syncthreads();
    for (int key = t; key < n; key += 256) {
        const bf16* kr = IK + ((size_t)b * S + key) * 64;
        float score = 0.f;
        for (int h = 0; h < 8; ++h) {
            float s = 0.f;
#pragma unroll 8
            for (int d = 0; d < 64; ++d) s += qh[h * 64 + d] * bf2f(kr[d]);
            s *= 0.125f;
            score += fmaxf(s, 0.f) * wq[h];
        }
        const unsigned u = __float_as_uint(score);
        keys[key] = (u & 0x80000000u) ? ~u : (u | 0x80000000u);
    }
    __syncthreads();
    unsigned* out = bm + (size_t)token * 128;
    if (n <= 256) { if (t < 128) { const int lo = t * 32; out[t] = (lo + 32 <= n) ? 0xffffffffu : 0u; } return; }
    unsigned prefix = 0u;
    for (int bit = 31; bit >= 0; --bit) {
        const unsigned cand = prefix | (1u << bit);
        int cnt = 0;
        for (int key = t; key < n; key += 256) cnt += (keys[key] >= cand) ? 1 : 0;
        cnt = block_sum_i(cnt, red);
        if (cnt >= 256) prefix = cand;
    }
    const unsigned Tv = prefix;
    int cgt = 0;
    for (int key = t; key < n; key += 256) cgt += (keys[key] > Tv) ? 1 : 0;
    cgt = block_sum_i(cgt, red);
    const int r = 256 - cgt;
    int I = 0;
    for (int bit = 11; bit >= 0; --bit) {
        const int cand = I | (1 << bit);
        int cnt = 0;
        for (int key = t; key < n; key += 256) cnt += (keys[key] == Tv && key < cand) ? 1 : 0;
        cnt = block_sum_i(cnt, red);
        if (cnt < r) I = cand;
    }
    if (t < 128) {
        unsigned w = 0u;
        for (int j = 0; j < 32; ++j) { const int key = t * 32 + j; if (key < n) { const unsigned kv = keys[key]; if (kv > Tv || (kv == Tv && key <= I)) w |= (1u << j); } }
        out[t] = w;
    }
}
}

extern "C" void kernel_launch(void* const* d_in, const int* in_sizes, int n_in, void* d_out, int out_size, void* d_ws, size_t ws_size, hipStream_t stream) {
    using namespace nv;
    if (n_in != 17 || ws_size < WS_END) { fprintf(stderr, "kernel_launch: unexpected n_in %d or ws_size %zu\n", n_in, ws_size); return; }
    const float* x = (const float*)d_in[0]; const float* mem = (const float*)d_in[1];
    const float* ln_in_g = (const float*)d_in[2]; const float* ln_in_b = (const float*)d_in[3];
    const float* w_in = (const float*)d_in[4]; const float* b_in = (const float*)d_in[5];
    const float* a_ln_g = (const float*)d_in[6]; const float* a_ln_b = (const float*)d_in[7];
    const float* a_ws = (const float*)d_in[8]; const float* a_bs = (const float*)d_in[9];
    const float* b_rel = (const float*)d_in[10]; const float* t5 = (const float*)d_in[11];
    const float* w_mem = (const float*)d_in[12]; const float* w_out = (const float*)d_in[13]; const float* b_out = (const float*)d_in[14];
    const float* ln_g = (const float*)d_in[15]; const float* ln_b = (const float*)d_in[16];
    unsigned char* ws = (unsigned char*)d_ws; float* out = (float*)d_out;
    float* tbl = (float*)(ws + WS_TBL);
    bf16* HB = (bf16*)(ws + WS_HB); bf16* MIX = (bf16*)(ws + WS_MIX); bf16* P13 = (bf16*)(ws + WS_P13);
    bf16* IQ = (bf16*)(ws + WS_IQ); bf16* IK = (bf16*)(ws + WS_IK); float* IW = (float*)(ws + WS_IW); unsigned* BM = (unsigned*)(ws + WS_BM);
    Route R{P13, IQ, IK, IW, out, nullptr, nullptr};
    auto grp = [&](int g) { return P13 + (size_t)g * T * GW; };
    hipLaunchKernelGGL(k_tables, dim3(5), dim3(256), 0, stream, t5, tbl);
    hipLaunchKernelGGL(k_ln_rows, dim3(T / 4), dim3(256), 0, stream, x, out, HB, ln_in_g, ln_in_b, T);
    for (int l = 0; l < 2; ++l) {
        bf16* KM = (bf16*)(ws + WS_KM) + (size_t)l * NB * NMEM * 256; bf16* VM = (bf16*)(ws + WS_VM) + (size_t)l * NB * NMEM * 256;
        Route Rm = R; Rm.km = KM; Rm.vm = VM;
        hipLaunchKernelGGL((k_gemm_naive<2, float>), dim3(512 / 64, NB * NMEM / 64), dim3(256), 0, stream, mem, w_mem + (size_t)l * D * 512, (const float*)nullptr, NB * NMEM, 512, D, Rm);
        hipLaunchKernelGGL((k_gemm_naive<0, bf16>), dim3((DIN + 63) / 64, T / 64), dim3(256), 0, stream, (const bf16*)HB, w_in + (size_t)l * D * DIN, b_in + (size_t)l * DIN, T, DIN, D, R);
        hipLaunchKernelGGL(k_a_ln, dim3(T / 4), dim3(256), 0, stream, grp(G_AV), a_ln_g + l * GW, a_ln_b + l * GW);
        hipLaunchKernelGGL(k_a_mix, dim3(T / 128, 4), dim3(256), 0, stream, (const bf16*)grp(G_AU), (const bf16*)grp(G_AV), (const bf16*)grp(G_AG), a_ws + (size_t)l * 4 * 128 * 128, a_bs + l * 4 * 128, MIX);
        hipLaunchKernelGGL((k_attn_naive<0>), dim3(T * 4 / 2), dim3(128), 0, stream, (const bf16*)grp(G_BQ), (const bf16*)grp(G_BK), (const bf16*)grp(G_BV), (const bf16*)grp(G_BG), MIX, 256, b_rel + (size_t)l * 4 * 257, (const unsigned*)nullptr);
        hipLaunchKernelGGL(k_c1_naive, dim3(T), dim3(256), 0, stream, (const bf16*)IQ, (const bf16*)IK, (const float*)IW, BM);
        hipLaunchKernelGGL((k_attn_naive<1>), dim3(T * 4 / 2), dim3(128), 0, stream, (const bf16*)grp(G_CQ), (const bf16*)grp(G_CK), (const bf16*)grp(G_CV), (const bf16*)grp(G_CG), MIX, 512, (const float*)tbl, (const unsigned*)BM);
        hipLaunchKernelGGL((k_attn_naive<2>), dim3(T * 4 / 2), dim3(128), 0, stream, (const bf16*)grp(G_MQ), (const bf16*)KM, (const bf16*)VM, (const bf16*)grp(G_MG), MIX, 768, (const float*)nullptr, (const unsigned*)nullptr);
        hipLaunchKernelGGL((k_gemm_naive<1, bf16>), dim3(D / 64, T / 64), dim3(256), 0, stream, (const bf16*)MIX, w_out + (size_t)l * D * D, b_out + (size_t)l * D, T, D, D, R);
        hipLaunchKernelGGL(k_ln_rows, dim3(T / 4), dim3(256), 0, stream, (const float*)out, out, HB, ln_g + l * D, ln_b + l * D, T);
    }
}
```

```cpp
#include <hip/hip_runtime.h>
#include <cstdio>
#include <cstdint>
namespace pg8 {
#define PG8_LAS __attribute__((address_space(3)))
typedef unsigned short bf16_t;
typedef short bf16x8 __attribute__((ext_vector_type(8)));
typedef float f32x4 __attribute__((ext_vector_type(4)));
typedef unsigned u32x4 __attribute__((ext_vector_type(4)));
constexpr int BM = 256, BK = 64, HALF = 128, HTB = HALF * BK * 2  , STAGE_BYTES = 8 * HTB, NXCD = 8, WGM = 8;

__host__ __device__ __forceinline__ int lds_byte(int r, int c) { const int st = (r >> 4) * 2 + (c >> 5), rr = r & 15, cc = c & 31, ob = rr * 64 + cc * 2; return st * 1024 + (ob ^ (((ob >> 9) & 1) << 5)); }
__host__ __device__ __forceinline__ void stage_rc(int b, int& R, int& C) { const int st = b / 1024, sb = b % 1024, swz = sb ^ (((sb >> 9) & 1) << 5); R = (st >> 1) * 16 + swz / 64; C = (st & 1) * 32 + (swz % 64) / 2; }
__host__ __device__ __forceinline__ int perm32(int rho) { const int n = rho >> 4, i = rho & 15; return 8 * (i >> 2) + 4 * n + (i & 3); }

struct Unit { int pm, pn; };
struct Gemm { const bf16_t* A; const bf16_t* Bt; int M, N, K; };

struct StaticOrder {
    int nM, nN, nwg, G, c;
    __host__ __device__ void init(int M, int N, int G_, int c_) { nM = M / BM; nN = N / BM; nwg = nM * nN; G = G_; c = c_; }
    __host__ __device__ bool next(int i, Unit& u) const {
        const long L = (long)i * G + c; if (L >= nwg) return false;
        int wgid = (int)L; { const int q = nwg / NXCD, r = nwg % NXCD, xcd = wgid % NXCD, off = wgid / NXCD; wgid = (xcd < r ? xcd * (q + 1) : r * (q + 1) + (xcd - r) * q) + off; }
        const int nig = WGM * nN, gid = wgid / nig, fm = gid * WGM, gsz = (nM - fm) < WGM ? (nM - fm) : WGM;
        u.pm = fm + ((wgid % nig) % gsz); u.pn = (wgid % nig) / gsz; return true;
    }
    __device__ __forceinline__ void a_ready(const Unit&) const {}
    __device__ __forceinline__ void done(const Unit&) const {}
};

__device__ __forceinline__ unsigned cvt_pk_bf16(float lo, float hi) { unsigned r; asm volatile("v_cvt_pk_bf16_f32 %0, %1, %2" : "=v"(r) : "v"(lo), "v"(hi)); return r; }
typedef float f32x2 __attribute__((ext_vector_type(2)));
template <class Epi, class Sched, bool ALIGN_EPI = false, bool SP2 = false>
__device__ __forceinline__ void gemm_phase(PG8_LAS unsigned char* lds, const Gemm g, const Sched& S, const Epi& E) {
    const int tid = threadIdx.x, wid = __builtin_amdgcn_readfirstlane(tid >> 6), lane = tid & 63, wr = wid >> 2, wc = wid & 3, fr = lane & 15, fq = lane >> 4;
    const int K = g.K, nt = K / BK;
    unsigned voffA[2], voffB[2];
#pragma unroll
    for (int i = 0; i < 2; ++i) { int R, C; stage_rc(tid * 16 + i * 8192, R, C); const int Rb = Epi::PERM ? ((R & ~31) + perm32(R & 31)) : R;
        voffA[i] = (unsigned)(R * K + C) * 2u; voffB[i] = (unsigned)(Rb * K + C) * 2u; }
    const size_t kstep = (size_t)(BK * 2);
    const size_t hstep = (size_t)HALF * K * 2;
    const size_t tstep = 2 * hstep;
    const unsigned ldsw = (unsigned)wid * 1024u;
    const int aoff = lds_byte(wr * 64 + fr, fq * 8), boff = lds_byte(wc * 32 + fr, fq * 8);
#define PG8_SA(b, h) (((b) * 2 + (h)) * HTB)
#define PG8_SB(b, h) ((4 + (b) * 2 + (h)) * HTB)
#define PG8_STAGE(bufoff, gbase, voff) do { _Pragma("unroll") for (int _i = 0; _i < 2; ++_i) \
        __builtin_amdgcn_global_load_lds((const unsigned*)((const char*)(gbase) + (voff)[_i]), (PG8_LAS unsigned*)(lds + (bufoff) + ldsw + _i * 8192), 16, 0, 0); } while (0)
#define PG8_LDA(dst, b, h) do { _Pragma("unroll") for (int m = 0; m < 4; ++m) _Pragma("unroll") for (int k = 0; k < 2; ++k) dst[m][k] = *(const PG8_LAS bf16x8*)(lds + PG8_SA(b, h) + aoff + m * 2048 + k * 1024); } while (0)
#define PG8_LDB(dst, b, h) do { _Pragma("unroll") for (int n = 0; n < 2; ++n) _Pragma("unroll") for (int k = 0; k < 2; ++k) dst[n][k] = *(const PG8_LAS bf16x8*)(lds + PG8_SB(b, h) + boff + n * 2048 + k * 1024); } while (0)
#define PG8_MMA(ai, bj, At, Bt) do { __builtin_amdgcn_s_setprio(1); _Pragma("unroll") for (int m = 0; m < 4; ++m) _Pragma("unroll") for (int n = 0; n < 2; ++n) _Pragma("unroll") for (int k = 0; k < 2; ++k) \
        acc[ai][bj][m][n] = __builtin_amdgcn_mfma_f32_16x16x32_bf16(Bt[n][k], At[m][k], acc[ai][bj][m][n], 0, 0, 0); __builtin_amdgcn_s_setprio(0); } while (0)
#define PG8_WAIT_V(n) asm volatile("s_waitcnt vmcnt(" #n ")" ::: "memory")
#define PG8_WAIT_L(n) asm volatile("s_waitcnt lgkmcnt(" #n ")" ::: "memory")
#define PG8_BAR __builtin_amdgcn_s_barrier()
#define PG8_SCHED __builtin_amdgcn_sched_barrier(0)
    Unit cur, nxt; int ui = 0;
    if (!S.next(0, cur)) return;
    f32x4 acc[2][2][4][2];
#pragma unroll
    for (int a = 0; a < 2; ++a)
#pragma unroll
        for (int b = 0; b < 2; ++b)
#pragma unroll
            for (int m = 0; m < 4; ++m)
#pragma unroll
                for (int n = 0; n < 2; ++n) acc[a][b][m][n] = (f32x4){0.f, 0.f, 0.f, 0.f};
    bf16x8 At[4][2], B0[2][2], B1[2][2];
    const char* cA = (const char*)g.A + (size_t)cur.pm * tstep; const char* cB = (const char*)g.Bt + (size_t)cur.pn * tstep;
    S.a_ready(cur);
    if constexpr (SP2) {
        PG8_STAGE(PG8_SB(0, 0), cB, voffB); PG8_STAGE(PG8_SB(0, 1), cB + hstep, voffB); PG8_STAGE(PG8_SA(0, 0), cA, voffA); PG8_STAGE(PG8_SA(0, 1), cA + hstep, voffA);
        if (wr == 1) PG8_BAR;
        PG8_WAIT_V(2); PG8_BAR;
        PG8_STAGE(PG8_SB(1, 0), cB + kstep, voffB); PG8_STAGE(PG8_SA(1, 0), cA + kstep, voffA); PG8_STAGE(PG8_SB(1, 1), cB + hstep + kstep, voffB);
        PG8_WAIT_V(6); PG8_BAR;
    } else {
        PG8_STAGE(PG8_SB(0, 0), cB, voffB); PG8_STAGE(PG8_SA(0, 0), cA, voffA); PG8_STAGE(PG8_SB(0, 1), cB + hstep, voffB); PG8_STAGE(PG8_SA(0, 1), cA + hstep, voffA);
        if (wr == 1) PG8_BAR;
        PG8_WAIT_V(4); PG8_BAR;
        PG8_STAGE(PG8_SB(1, 0), cB + kstep, voffB); PG8_STAGE(PG8_SA(1, 0), cA + kstep, voffA); PG8_STAGE(PG8_SB(1, 1), cB + hstep + kstep, voffB);
        PG8_WAIT_V(6); PG8_BAR;
    }
    for (;;) {
        const bool has_next = S.next(ui + 1, nxt);
        const char* nA = has_next ? (const char*)g.A + (size_t)nxt.pm * tstep : cA; const char* nB = has_next ? (const char*)g.Bt + (size_t)nxt.pn * tstep : cB;
        for (int t = 0; t < nt; t += 2) {
            const bool last = (t == nt - 2);
            const char* a1 = cA + (size_t)(t + 1) * kstep;
            const char* a2 = last ? nA : cA + (size_t)(t + 2) * kstep; const char* b2 = last ? nB : cB + (size_t)(t + 2) * kstep;
            const char* a3 = a2 + kstep; const char* b3 = b2 + kstep;
            if (last && has_next) S.a_ready(nxt);
            if constexpr (SP2) {
            PG8_LDB(B0, 0, 0); PG8_LDB(B1, 0, 1); PG8_SCHED; PG8_LDA(At, 0, 0); PG8_STAGE(PG8_SA(1, 1), a1 + hstep, voffA);
            PG8_WAIT_V(8); PG8_WAIT_L(0); PG8_BAR; PG8_MMA(0, 0, At, B0); PG8_MMA(0, 1, At, B1); PG8_BAR; PG8_SCHED;
            PG8_LDA(At, 0, 1); PG8_STAGE(PG8_SB(0, 0), b2, voffB); PG8_STAGE(PG8_SB(0, 1), b2 + hstep, voffB); PG8_STAGE(PG8_SA(0, 0), a2, voffA);
            PG8_WAIT_V(8); PG8_WAIT_L(0); PG8_BAR; PG8_MMA(1, 0, At, B0); PG8_MMA(1, 1, At, B1); PG8_BAR; PG8_SCHED;
            PG8_LDB(B0, 1, 0); PG8_LDB(B1, 1, 1); PG8_SCHED; PG8_LDA(At, 1, 0); PG8_STAGE(PG8_SA(0, 1), a2 + hstep, voffA);
            PG8_WAIT_V(8); PG8_WAIT_L(0); PG8_BAR; PG8_MMA(0, 0, At, B0); PG8_MMA(0, 1, At, B1); PG8_BAR; PG8_SCHED;
            PG8_LDA(At, 1, 1); PG8_STAGE(PG8_SB(1, 0), b3, voffB); PG8_STAGE(PG8_SB(1, 1), b3 + hstep, voffB); PG8_STAGE(PG8_SA(1, 0), a3, voffA);
            PG8_WAIT_V(8); PG8_WAIT_L(0); PG8_BAR; PG8_MMA(1, 0, At, B0); PG8_MMA(1, 1, At, B1); PG8_BAR; PG8_SCHED;
            } else {
            PG8_LDB(B0, 0, 0); PG8_SCHED; PG8_LDA(At, 0, 0); PG8_STAGE(PG8_SA(1, 1), a1 + hstep, voffA);
            PG8_WAIT_L(8); PG8_BAR; PG8_WAIT_L(0); PG8_MMA(0, 0, At, B0); PG8_BAR; PG8_SCHED;
            PG8_LDB(B1, 0, 1); PG8_STAGE(PG8_SB(0, 0), b2, voffB);
            PG8_BAR; PG8_WAIT_L(0); PG8_MMA(0, 1, At, B1); PG8_BAR;
            PG8_LDA(At, 0, 1); PG8_STAGE(PG8_SA(0, 0), a2, voffA);
            PG8_BAR; PG8_WAIT_L(0); PG8_MMA(1, 0, At, B0); PG8_BAR; PG8_SCHED;
            PG8_STAGE(PG8_SB(0, 1), b2 + hstep, voffB);
            PG8_WAIT_V(6); PG8_BAR; PG8_MMA(1, 1, At, B1); PG8_BAR;
            PG8_LDB(B0, 1, 0); PG8_SCHED; PG8_LDA(At, 1, 0); PG8_STAGE(PG8_SA(0, 1), a2 + hstep, voffA);
            PG8_WAIT_L(8); PG8_BAR; PG8_WAIT_L(0); PG8_MMA(0, 0, At, B0); PG8_BAR; PG8_SCHED;
            PG8_LDB(B1, 1, 1); PG8_STAGE(PG8_SB(1, 0), b3, voffB);
            PG8_BAR; PG8_WAIT_L(0); PG8_MMA(0, 1, At, B1); PG8_BAR;
            PG8_LDA(At, 1, 1); PG8_STAGE(PG8_SA(1, 0), a3, voffA);
            PG8_BAR; PG8_WAIT_L(0); PG8_MMA(1, 0, At, B0); PG8_BAR; PG8_SCHED;
            PG8_STAGE(PG8_SB(1, 1), b3 + hstep, voffB);
            PG8_WAIT_V(6); PG8_BAR; PG8_MMA(1, 1, At, B1); PG8_BAR;
            }
        }
        if constexpr (ALIGN_EPI) { if (wr == 0) PG8_BAR; }
        if constexpr (!Epi::AFTER_DRAIN) { E(acc, cur, wr, wc, fr, fq); S.done(cur); }
        if (!has_next) break;
#pragma unroll
        for (int a = 0; a < 2; ++a)
#pragma unroll
            for (int b = 0; b < 2; ++b)
#pragma unroll
                for (int m = 0; m < 4; ++m)
#pragma unroll
                    for (int n = 0; n < 2; ++n) acc[a][b][m][n] = (f32x4){0.f, 0.f, 0.f, 0.f};
        cur = nxt; cA = nA; cB = nB; ++ui;
        if constexpr (ALIGN_EPI) { if (wr == 1) PG8_BAR; }
    }
    PG8_WAIT_V(0);
    if constexpr (!ALIGN_EPI) { if (wr == 0) PG8_BAR; }
    PG8_BAR;
    if constexpr (Epi::AFTER_DRAIN) { E.fused(acc, cur, wr, wc, fr, fq, lds, wid, lane); S.done(cur); }
#undef PG8_SA
#undef PG8_SB
#undef PG8_STAGE
#undef PG8_LDA
#undef PG8_LDB
#undef PG8_MMA
#undef PG8_WAIT_V
#undef PG8_WAIT_L
#undef PG8_BAR
#undef PG8_SCHED
}
}
typedef unsigned short bf16;
constexpr int NB = 8, S = 4096, D = 1024, T = NB * S, GW = 256, DIN = 3912, DINP = 4096, NMEM = 256;
constexpr float LN_EPS = 1e-5f;
constexpr float ALPHA = 1.41421356237309515f;
constexpr size_t MiB = 1u << 20;
constexpr size_t WS_CTL = 0, CTL_ZERO_BYTES = 1 * MiB;
constexpr size_t WS_WIN = 2 * MiB;
constexpr size_t WS_WOUT = 18 * MiB;
constexpr size_t WS_TBL = 22 * MiB;
constexpr size_t WS_KM = 24 * MiB;
constexpr size_t WS_VM = 26 * MiB;
constexpr size_t WS_HB = 32 * MiB;
constexpr size_t WS_MIX = 96 * MiB;
constexpr size_t WS_P13 = 160 * MiB;
constexpr size_t WS_IQ = 368 * MiB;
constexpr size_t WS_IK = 400 * MiB;
constexpr size_t WS_IW = 404 * MiB;
constexpr size_t WS_END = 406 * MiB;
enum Grp { G_AU = 0, G_AV, G_AG, G_BQ, G_BK, G_BV, G_BG, G_CQ, G_CK, G_CV, G_CG, G_MQ, G_MG };
constexpr int CW_BAR = 4096;

__device__ __forceinline__ float bf2f(bf16 v) { return __uint_as_float((unsigned)v << 16); }
__device__ __forceinline__ bf16 f2bf(float f) { unsigned u = __float_as_uint(f); return (bf16)((u + 0x7fffu + ((u >> 16) & 1u)) >> 16); }
__device__ __forceinline__ float fast_sigmoid(float x) { return __builtin_amdgcn_rcpf(1.f + __builtin_amdgcn_exp2f(-1.4426950408889634f * x)); }
__device__ __forceinline__ float gelu_tanh(float x) { const float u = 0.7978845608028654f * (x + 0.044715f * x * x * x); return x * fast_sigmoid(2.f * u); }
__device__ __forceinline__ float silu(float x) { return x * fast_sigmoid(x); }
__device__ __forceinline__ float wave_sum(float v) {
#pragma unroll
    for (int o = 1; o < 64; o <<= 1) v += __shfl_xor(v, o);
    return v;
}
__device__ __forceinline__ float wave_max(float v) {
#pragma unroll
    for (int o = 1; o < 64; o <<= 1) v = fmaxf(v, __shfl_xor(v, o));
    return v;
}
__host__ __device__ __forceinline__ int perm_col(int col) {
    if (col < 3328) return col;
    if (col < 3392) return 3840 + (col - 3328);
    if (col < 3400) return 3904 + (col - 3392);
    if (col < 3656) return 3328 + (col - 3400);
    return 3584 + (col - 3656);
}

namespace pg8 {
__device__ __forceinline__ f32x4 act4(f32x4 v, int mode) {
    if (mode == 1) { v[0] = gelu_tanh(v[0]); v[1] = gelu_tanh(v[1]); v[2] = gelu_tanh(v[2]); v[3] = gelu_tanh(v[3]); }
    else if (mode == 2) { v[0] = silu(v[0]); v[1] = silu(v[1]); v[2] = silu(v[2]); v[3] = silu(v[3]); }
    else if (mode == 3) { v = v * 0.125f; }
    return v;
}
struct EpiRoute {
    static constexpr bool PERM = true, AFTER_DRAIN = false;
    bf16_t* p13; bf16_t* iq; bf16_t* ik; float* iw; const float* bias;
    __device__ __forceinline__ void operator()(const f32x4 (&acc)[2][2][4][2], const Unit& u, int wr, int wc, int fr, int fq) const {
        const int pn = u.pn, row0 = u.pm * BM + wr * 64 + fr, cl0 = wc * 32 + 8 * fq;
        f32x4 bv[2][2];
#pragma unroll
        for (int bj = 0; bj < 2; ++bj)
#pragma unroll
            for (int n = 0; n < 2; ++n) bv[bj][n] = *(const f32x4*)(bias + pn * BM + bj * HALF + cl0 + 4 * n);
        if (pn == 15) {
#pragma unroll
            for (int ai = 0; ai < 2; ++ai)
#pragma unroll
                for (int m = 0; m < 4; ++m) { const size_t row = (size_t)(row0 + ai * HALF + m * 16);
                    const f32x4 v0 = acc[ai][0][m][0] + bv[0][0], v1 = acc[ai][0][m][1] + bv[0][1];
                    if (wc < 2) { u32x4 w; w.x = cvt_pk_bf16(v0[0], v0[1]); w.y = cvt_pk_bf16(v0[2], v0[3]); w.z = cvt_pk_bf16(v1[0], v1[1]); w.w = cvt_pk_bf16(v1[2], v1[3]); *(u32x4*)(ik + row * 64 + cl0) = w; }
                    else if (wc == 2 && fq == 0) { *(f32x4*)(iw + row * 8) = v0; *(f32x4*)(iw + row * 8 + 4) = v1; } }
            return;
        }
        bf16_t* base; int ldc, mode;
        if (pn <= 10) { base = p13 + (size_t)pn * T * GW; ldc = GW; mode = (pn == G_AU || pn == G_AV) ? 1 : (pn == G_AG || pn == G_BG || pn == G_CG) ? 2 : (pn == G_BQ || pn == G_CQ) ? 3 : 0; }
        else if (pn <= 12) { base = iq + (pn - 11) * 256; ldc = 512; mode = 0; }
        else if (pn == 13) { base = p13 + (size_t)G_MQ * T * GW; ldc = GW; mode = 3; }
        else { base = p13 + (size_t)G_MG * T * GW; ldc = GW; mode = 2; }
#pragma unroll
        for (int ai = 0; ai < 2; ++ai)
#pragma unroll
            for (int m = 0; m < 4; ++m) { bf16_t* rowp = base + (size_t)(row0 + ai * HALF + m * 16) * ldc + cl0;
#pragma unroll
                for (int bj = 0; bj < 2; ++bj) { const f32x4 v0 = act4(acc[ai][bj][m][0] + bv[bj][0], mode), v1 = act4(acc[ai][bj][m][1] + bv[bj][1], mode);
                    u32x4 w; w.x = cvt_pk_bf16(v0[0], v0[1]); w.y = cvt_pk_bf16(v0[2], v0[3]); w.z = cvt_pk_bf16(v1[0], v1[1]); w.w = cvt_pk_bf16(v1[2], v1[3]);
                    *(u32x4*)(rowp + bj * HALF) = w; } }
    }
};
struct EpiResid {
    static constexpr bool PERM = false, AFTER_DRAIN = false;
    float* out; const float* bias;
    __device__ __forceinline__ void operator()(const f32x4 (&acc)[2][2][4][2], const Unit& u, int wr, int wc, int fr, int fq) const {
        const int col0 = u.pn * BM + wc * 32 + 4 * fq;
#pragma unroll
        for (int ai = 0; ai < 2; ++ai)
#pragma unroll
            for (int m = 0; m < 4; ++m) { float* rowp = out + (size_t)(u.pm * BM + ai * HALF + wr * 64 + m * 16 + fr) * D + col0;
#pragma unroll
                for (int bj = 0; bj < 2; ++bj)
#pragma unroll
                    for (int n = 0; n < 2; ++n) { float* p = rowp + bj * HALF + n * 16; const f32x4 bv = *(const f32x4*)(bias + col0 + bj * HALF + n * 16);
                        const f32x4 h = *(const f32x4*)p; *(f32x4*)p = h * ALPHA + acc[ai][bj][m][n] + bv; } }
    }
};
}
#define GAS __attribute__((address_space(1)))
#define LAS __attribute__((address_space(3)))
typedef unsigned short bf16;
typedef unsigned v4u __attribute__((ext_vector_type(4)));
typedef float f32x4 __attribute__((ext_vector_type(4)));
typedef short bf16x8 __attribute__((ext_vector_type(8)));
typedef GAS unsigned gu32;
typedef GAS unsigned long long gu64;
#define RLX_AGENT __ATOMIC_RELAXED, __HIP_MEMORY_SCOPE_AGENT
#define LDS_WAIT() asm volatile("s_waitcnt lgkmcnt(0)" ::: "memory")
#define VM_WAIT() asm volatile("s_waitcnt vmcnt(0)" ::: "memory")
__device__ __forceinline__ unsigned long long rt() { return __builtin_amdgcn_s_memrealtime(); }
__device__ __forceinline__ unsigned pk2(float lo, float hi) { return (unsigned)f2bf(lo) | ((unsigned)f2bf(hi) << 16); }

#define XB_TMO      128
#define XB_XCNT(j)  (256  + 64 * (j))
#define XB_XSUB(j)  (1280 + 64 * (j))
#define XB_XGEN(j)  (2304 + 64 * (j))
#define XB_TOP      3328
#define XB_TOPGEN   3392
#define XCD_BAR_WORDS 3456
#define XB_SPIN_CAP (1u << 18)

__device__ __forceinline__ unsigned xb_ld(unsigned* p)              { return __hip_atomic_load(p, __ATOMIC_RELAXED, __HIP_MEMORY_SCOPE_AGENT); }
__device__ __forceinline__ unsigned xb_add(unsigned* p, unsigned v) { return __hip_atomic_fetch_add(p, v, __ATOMIC_RELAXED, __HIP_MEMORY_SCOPE_AGENT); }
__device__ __forceinline__ unsigned xb_xcc_id() { return (unsigned)__builtin_amdgcn_s_getreg((3 << 11) | 20) & 0xFu; }
#define XB_SPIN(cond, bar) do { unsigned _sp = 0; while (cond) { __builtin_amdgcn_s_sleep(1); \
    if ((++_sp & 255u) == 0u) { if (xb_ld(&(bar)[XB_TMO])) break; if (_sp > XB_SPIN_CAP) { atomicAdd(&(bar)[XB_TMO], 1u); break; } } } } while (0)

struct XcdBarrier {
    unsigned* bar; unsigned x;
    volatile LAS unsigned* st;
};

__device__ __forceinline__ XcdBarrier xcd_barrier_post(unsigned* bar, volatile LAS unsigned* st) {
    XcdBarrier b; b.bar = bar; b.x = xb_xcc_id(); b.st = st;
    if (threadIdx.x == 0) (void)xb_add(&bar[XB_XCNT(b.x)], 1u);
    return b;
}
__device__ __forceinline__ void xcd_barrier_complete(unsigned* bar, unsigned x, unsigned& nloc, unsigned& nx) {
    const unsigned G = gridDim.x * gridDim.y * gridDim.z;
    unsigned sum, cnt, mine, sp = 0u;
    for (;;) {
        sum = 0u; cnt = 0u; mine = 0u;
#pragma unroll
        for (unsigned j = 0; j < 16; ++j) { const unsigned c = xb_ld(&bar[XB_XCNT(j)]); sum += c; cnt += (c > 0u) ? 1u : 0u; mine = (j == x) ? c : mine; }
        if (sum == G) break;
        __builtin_amdgcn_s_sleep(1);
        if ((++sp & 255u) == 0u) { if (xb_ld(&bar[XB_TMO])) break; if (sp > XB_SPIN_CAP) { atomicAdd(&bar[XB_TMO], 1u); break; } }
    }
    nloc = mine > 0u ? mine : 1u; nx = cnt > 0u ? cnt : 1u;
}

__device__ __forceinline__ void xcd_barrier(const XcdBarrier& b) {
    asm volatile("s_waitcnt vmcnt(0)" ::: "memory");
    __syncthreads();
    if (threadIdx.x == 0) {
        unsigned* bar = b.bar;
        __builtin_amdgcn_s_waitcnt(0);
        unsigned nloc = b.st[0], nx = b.st[1];
        if (nloc == 0u) { xcd_barrier_complete(bar, b.x, nloc, nx); b.st[0] = nloc; b.st[1] = nx; }
        const unsigned old = xb_add(&bar[XB_XSUB(b.x)], 1u);
        const unsigned gen = old / nloc;
        if (old + 1u == (gen + 1u) * nloc) {
            __builtin_amdgcn_fence(__ATOMIC_RELEASE, "agent");
            asm volatile("s_waitcnt vmcnt(0)" ::: "memory");
            const unsigned og = xb_add(&bar[XB_TOP], 1u);
            const unsigned tg = og / nx;
            if (og + 1u == (tg + 1u) * nx) xb_add(&bar[XB_TOPGEN], 1u);
            else XB_SPIN(xb_ld(&bar[XB_TOPGEN]) == tg, bar);
            __builtin_amdgcn_fence(__ATOMIC_ACQUIRE, "agent");
            xb_add(&bar[XB_XGEN(b.x)], 1u);
            asm volatile("s_waitcnt vmcnt(0)" ::: "memory");
        } else {
            XB_SPIN(xb_ld(&bar[XB_XGEN(b.x)]) == gen, bar);
            __builtin_amdgcn_fence(__ATOMIC_ACQUIRE, "agent");
            asm volatile("s_waitcnt vmcnt(0)" ::: "memory");
        }
    }
    __syncthreads();
}
constexpr int RING_OFF = 0, RING_BYTES = 131072;
constexpr int LDSCTL_OFF = RING_BYTES, MISC_OFF = LDSCTL_OFF + 320;
constexpr int SCR_OFF = LDSCTL_OFF + 1024;
constexpr int LDS_BYTES = 147456;
constexpr int NWAVES = 8;

struct Args { const float* in[17]; float* out; unsigned char* ws; };

__device__ __forceinline__ void transpose_item(const float* W, int N, bf16* WT, bool perm, LAS float* scr, int item, int lane) {
    const int nblk = (N + 31) / 32, kb = item / nblk, nb = item % nblk, k0 = 64 * kb, n0 = 32 * nb;
    const bool nok = n0 + (lane & 31) < N;
#pragma unroll 8
    for (int i = 0; i < 32; ++i) { const int kk = 2 * i + (lane >> 5); scr[kk * 33 + (lane & 31)] = nok ? W[(size_t)(k0 + kk) * N + n0 + (lane & 31)] : 0.f; }
    asm volatile("s_waitcnt lgkmcnt(0)" ::: "memory");
    const int c = lane & 7;
#pragma unroll
    for (int j = 0; j < 4; ++j) { const int n = (lane >> 3) + 8 * j; const LAS float* s = scr + (8 * c) * 33 + n;
        if (n0 + n < N) {
            v4u o; o.x = pk2(s[0 * 33], s[1 * 33]); o.y = pk2(s[2 * 33], s[3 * 33]); o.z = pk2(s[4 * 33], s[5 * 33]); o.w = pk2(s[6 * 33], s[7 * 33]);
            const int drow = perm ? perm_col(n0 + n) : (n0 + n);
            *(GAS v4u*)(WT + (size_t)drow * 1024 + k0 + 8 * c) = o; } }
    asm volatile("s_waitcnt lgkmcnt(0)" ::: "memory");
}
__device__ __forceinline__ void ln_row(const float* in, float* out, bf16* outb, const float* g, const float* b, int lane) {
    const f32x4* xr = (const f32x4*)in + lane;
    f32x4 v[4]; float s = 0.f;
#pragma unroll
    for (int j = 0; j < 4; ++j) { v[j] = xr[64 * j]; s += (v[j].x + v[j].y) + (v[j].z + v[j].w); }
    const float mean = wave_sum(s) * (1.f / D); float s2 = 0.f;
#pragma unroll
    for (int j = 0; j < 4; ++j) { v[j] = v[j] - mean; s2 += (v[j].x * v[j].x + v[j].y * v[j].y) + (v[j].z * v[j].z + v[j].w * v[j].w); }
    const float rstd = rsqrtf(wave_sum(s2) * (1.f / D) + LN_EPS);
#pragma unroll
    for (int j = 0; j < 4; ++j) {
        const int c = 4 * (lane + 64 * j);
        const f32x4 o = v[j] * rstd * *(const f32x4*)(g + c) + *(const f32x4*)(b + c);
        *(f32x4*)(out + c) = o;
        *(unsigned long long*)(outb + c) = (unsigned long long)pk2(o.x, o.y) | ((unsigned long long)pk2(o.z, o.w) << 32);
    }
}
__device__ __forceinline__ void memkv_tile(const float* A, const float* W, bf16* km, bf16* vm, int tm, int tn, LAS float* As, LAS float* Bs, int tid) {
    const int tx = tid & 15, ty = tid >> 4, m0 = tm * 128, n0 = tn * 64;
    float acc[4][4];
#pragma unroll
    for (int i = 0; i < 4; ++i)
#pragma unroll
        for (int j = 0; j < 4; ++j) acc[i][j] = 0.f;
    for (int k0 = 0; k0 < D; k0 += 16) {
#pragma unroll
        for (int i = 0; i < 4; ++i) { const int e = tid + 512 * i, r = e >> 4, kk = e & 15; As[kk * 129 + r] = A[(size_t)(m0 + r) * D + k0 + kk]; }
#pragma unroll
        for (int i = 0; i < 2; ++i) { const int e = tid + 512 * i, kk = e >> 6, c = e & 63; Bs[kk * 65 + c] = W[(size_t)(k0 + kk) * 512 + n0 + c]; }
        __syncthreads();
#pragma unroll
        for (int kk = 0; kk < 16; ++kk) {
            float a[4], b[4];
#pragma unroll
            for (int i = 0; i < 4; ++i) { a[i] = As[kk * 129 + ty * 4 + i]; b[i] = Bs[kk * 65 + tx * 4 + i]; }
#pragma unroll
            for (int i = 0; i < 4; ++i)
#pragma unroll
                for (int j = 0; j < 4; ++j) acc[i][j] += a[i] * b[j];
        }
        __syncthreads();
    }
#pragma unroll
    for (int i = 0; i < 4; ++i)
#pragma unroll
        for (int j = 0; j < 4; ++j) { const int row = m0 + ty * 4 + i, col = n0 + tx * 4 + j;
            if (col < 256) km[(size_t)row * 256 + col] = f2bf(acc[i][j]); else vm[(size_t)row * 256 + col - 256] = f2bf(acc[i][j]); }
}

__device__ __forceinline__ void mixer_a_unit(int blk, const bf16* au, const bf16* av, const bf16* ag, const float* lng, const float* lnb, const float* ws_, const float* bs, bf16* mix, LAS float* vt, int tid) {
    const int wave = tid >> 6, lane = tid & 63;
    const size_t row0 = (size_t)blk * 128;
    for (int r = wave; r < 128; r += NWAVES) {
        const bf16* p = av + (row0 + r) * GW + lane * 4;
        float v[4]; float s = 0.f;
#pragma unroll
        for (int j = 0; j < 4; ++j) { v[j] = bf2f(p[j]); s += v[j]; }
        const float mean = wave_sum(s) * (1.f / GW); float s2 = 0.f;
#pragma unroll
        for (int j = 0; j < 4; ++j) { v[j] -= mean; s2 += v[j] * v[j]; }
        const float rstd = rsqrtf(wave_sum(s2) * (1.f / GW) + LN_EPS);
#pragma unroll
        for (int j = 0; j < 4; ++j) vt[r * 256 + lane * 4 + j] = bf2f(f2bf(v[j] * rstd * lng[lane * 4 + j] + lnb[lane * 4 + j]));
    }
    __syncthreads();
    const int ch = tid & 255, g = ch >> 6;
    for (int i = tid >> 8; i < 128; i += 2) {
        const float* wr = ws_ + ((size_t)g * 128 + i) * 128;
        const int jmax = i < 64 ? 64 : 128;
        float acc = 0.f;
        for (int j = 0; j < jmax; ++j) acc += wr[j] * vt[j * 256 + ch];
        acc += bs[g * 128 + i];
        const size_t idx = (row0 + i) * GW + ch;
        mix[(row0 + i) * D + ch] = f2bf(bf2f(au[idx]) * acc * bf2f(ag[idx]));
    }
    __syncthreads();
}
template <int MODE>
__device__ __forceinline__ void attn_wave(int token, int h, const bf16* Q, const bf16* K, const bf16* V, const bf16* G, bf16* mix, int colofs, const float* tbl,
                                          LAS float* sc, LAS float* qs, const LAS unsigned* keys, unsigned Tv, int Ti, int lane) {
    const int b = token / S, pos = token % S, c = pos >> 6;
    int k0, k1; size_t kbase;
    if (MODE == 0) { k0 = (c >= 8 ? c - 8 : 0) * 64; k1 = (c + 1) * 64; kbase = (size_t)b * S; }
    else if (MODE == 1) { k0 = 0; k1 = (c + 1) * 64; kbase = (size_t)b * S; }
    else { k0 = 0; k1 = NMEM; kbase = (size_t)b * NMEM; }
    qs[lane] = bf2f(Q[(size_t)token * GW + h * 64 + lane]);
    asm volatile("s_waitcnt lgkmcnt(0)" ::: "memory");
    float mx = -INFINITY;
    for (int key = k0 + lane; key < k1; key += 64) {
        const bf16* kr = K + (kbase + key) * GW + h * 64;
        float s = 0.f;
#pragma unroll 8
        for (int d = 0; d < 64; ++d) s += qs[d] * bf2f(kr[d]);
        if (MODE != 2) { int dd = pos - key; dd = dd < -128 ? -128 : (dd > 128 ? 128 : dd); s += tbl[h * 257 + dd + 128]; }
        if (MODE == 1) { const unsigned kv = keys[key]; if (!(kv > Tv || (kv == Tv && key <= Ti))) s = -INFINITY; }
        sc[key - k0] = s; mx = fmaxf(mx, s);
    }
    mx = wave_max(mx);
    float sum = 0.f;
    for (int key = k0 + lane; key < k1; key += 64) { const float p = __expf(sc[key - k0] - mx); sc[key - k0] = p; sum += p; }
    sum = wave_sum(sum);
    asm volatile("s_waitcnt lgkmcnt(0)" ::: "memory");
    float o = 0.f;
    for (int key = k0; key < k1; ++key) { const float p = sc[key - k0]; if (p != 0.f) o += p * bf2f(V[(kbase + key) * GW + h * 64 + lane]); }
    o /= sum;
    mix[(size_t)token * D + colofs + h * 64 + lane] = f2bf(o * bf2f(G[(size_t)token * GW + h * 64 + lane]));
    asm volatile("s_waitcnt lgkmcnt(0)" ::: "memory");
}
__device__ __forceinline__ int block_sum_i(int v, volatile LAS int* red, int tid) {
#pragma unroll
    for (int o = 1; o < 64; o <<= 1) v += __shfl_xor(v, o);
    __syncthreads();
    if ((tid & 63) == 0) red[tid >> 6] = v;
    __syncthreads();
    int s = 0;
#pragma unroll
    for (int w = 0; w < NWAVES; ++w) s += red[w];
    return s;
}
__device__ __forceinline__ void mixer_c_token(int token, const bf16* IQ, const bf16* IK, const float* IW, const bf16* Q, const bf16* K, const bf16* V, const bf16* G, bf16* mix, const float* tbl,
                                              LAS unsigned char* lds, int tid) {
    LAS unsigned* keys = (LAS unsigned*)(lds + RING_OFF);
    LAS float* qh = (LAS float*)(lds + SCR_OFF + 4096);
    LAS float* wq = (LAS float*)(lds + SCR_OFF + 4096 + 2048);
    volatile LAS int* red = (volatile LAS int*)(lds + SCR_OFF + 4096 + 2048 + 64);
    const int wave = tid >> 6, lane = tid & 63;
    const int b = token / S, pos = token % S, c = pos >> 6, n = (c + 1) * 64;
    qh[tid] = bf2f(IQ[(size_t)token * 512 + tid]);
    if (tid < 8) wq[tid] = IW[(size_t)token * 8 + tid] * 0.35355339059327373f;
    __syncthreads();
    for (int key = tid; key < n; key += 512) {
        const bf16* kr = IK + ((size_t)b * S + key) * 64;
        float score = 0.f;
        for (int h = 0; h < 8; ++h) {
            float s = 0.f;
#pragma unroll 8
            for (int d = 0; d < 64; ++d) s += qh[h * 64 + d] * bf2f(kr[d]);
            s *= 0.125f;
            score += fmaxf(s, 0.f) * wq[h];
        }
        const unsigned u = __float_as_uint(score);
        keys[key] = (u & 0x80000000u) ? ~u : (u | 0x80000000u);
    }
    __syncthreads();
    unsigned Tv = 0u; int Ti = 4095;
    if (n > 256) {
        unsigned prefix = 0u;
        for (int bit = 31; bit >= 0; --bit) {
            const unsigned cand = prefix | (1u << bit);
            int cnt = 0;
            for (int key = tid; key < n; key += 512) cnt += (keys[key] >= cand) ? 1 : 0;
            cnt = block_sum_i(cnt, red, tid);
            if (cnt >= 256) prefix = cand;
        }
        Tv = prefix;
        int cgt = 0;
        for (int key = tid; key < n; key += 512) cgt += (keys[key] > Tv) ? 1 : 0;
        cgt = block_sum_i(cgt, red, tid);
        const int r = 256 - cgt;
        int I = 0;
        for (int bit = 11; bit >= 0; --bit) {
            const int cand = I | (1 << bit);
            int cnt = 0;
            for (int key = tid; key < n; key += 512) cnt += (keys[key] == Tv && key < cand) ? 1 : 0;
            cnt = block_sum_i(cnt, red, tid);
            if (cnt < r) I = cand;
        }
        Ti = I;
    }
    if (wave < 4) attn_wave<1>(token, wave, Q, K, V, G, mix, 512, tbl, (LAS float*)(lds + RING_OFF + 16384 + wave * 16384), (LAS float*)(lds + SCR_OFF + wave * 256), keys, Tv, Ti, lane);
    __syncthreads();
}

template <int OFF> __device__ __forceinline__ unsigned long long karg_u64() {
    const __attribute__((address_space(4))) char* k = (const __attribute__((address_space(4))) char*)__builtin_amdgcn_kernarg_segment_ptr();
    unsigned long long v;
    asm volatile("s_load_dwordx2 %0, %1, %2\n\ts_waitcnt lgkmcnt(0)" : "=s"(v) : "s"(k), "i"(OFF) : "memory");
    return v;
}
#define IN_PTR(i) ((const float*)karg_u64<8 * (i)>())
#define OUT_PTR() ((float*)karg_u64<8 * 17>())
#define WS_PTR() ((unsigned char*)karg_u64<8 * 18>())
#define GRP(g) ((bf16*)(WS_PTR() + WS_P13) + (size_t)(g) * T * GW)
#define GRID_BAR() do { XcdBarrier b_; b_.bar = (unsigned*)((gu32*)(WS_PTR() + WS_CTL) + CW_BAR); b_.x = xb_xcc_id(); b_.st = (volatile LAS unsigned*)((LAS unsigned char*)lds_raw + MISC_OFF) + 8; xcd_barrier(b_); } while (0)

__global__ void __launch_bounds__(NWAVES * 64, 2) mk_fwd(Args args) {
    extern __shared__ __attribute__((aligned(16))) unsigned char lds_raw[];
    {
        LAS unsigned char* lds = (LAS unsigned char*)lds_raw;
        for (int u = threadIdx.x; u < (LDS_BYTES - LDSCTL_OFF) / 4; u += NWAVES * 64) ((LAS unsigned*)(lds + LDSCTL_OFF))[u] = 0u;
        __syncthreads();
        (void)xcd_barrier_post((unsigned*)((gu32*)(WS_PTR() + WS_CTL) + CW_BAR), (volatile LAS unsigned*)(lds + MISC_OFF) + 8);
    }
    {
        LAS unsigned char* lds = (LAS unsigned char*)lds_raw;
        const int tid = threadIdx.x, lane = tid & 63, wave = __builtin_amdgcn_readfirstlane(tid >> 6);
        const int G = gridDim.x, bx = blockIdx.x, vcu = (G % 8 == 0) ? (bx % 8) * (G / 8) + bx / 8 : bx;
        const int gw = vcu * NWAVES + wave, NGW = G * NWAVES;
        unsigned char* ws = WS_PTR();
        const float* w_in = IN_PTR(4); const float* w_out = IN_PTR(13);
        bf16* WIN = (bf16*)(ws + WS_WIN); bf16* WOUT = (bf16*)(ws + WS_WOUT);
        float* tbl = (float*)(ws + WS_TBL); float* bperm = (float*)(ws + WS_TBL + 65536);
        LAS float* scr = (LAS float*)(lds + RING_OFF + wave * 16384);
        constexpr int I_IN = 16 * 123, I_OUT = 16 * 32;
        for (int it = gw; it < 2 * I_IN + 2 * I_OUT; it += NGW) {
            int r = it;
            if (r < 2 * I_IN) { const int l = r / I_IN; transpose_item(w_in + (size_t)l * D * DIN, DIN, WIN + (size_t)l * DINP * D, true, scr, r % I_IN, lane); }
            else { r -= 2 * I_IN; const int l = r / I_OUT; transpose_item(w_out + (size_t)l * D * D, D, WOUT + (size_t)l * D * D, false, scr, r % I_OUT, lane); }
        }
        { const float* b_in = IN_PTR(5);
          for (int i = bx * 512 + tid; i < 2 * DINP; i += G * 512) { const int l = i / DINP, p = i % DINP; int col = -1;
              if (p < 3328) col = p; else if (p < 3584) col = 3400 + (p - 3328); else if (p < 3840) col = 3656 + (p - 3584); else if (p < 3904) col = 3328 + (p - 3840); else if (p < 3912) col = 3392 + (p - 3904);
              bperm[i] = col >= 0 ? b_in[l * DIN + col] : 0.f; } }
        { const float* t5 = IN_PTR(11);
          for (int i = bx * 512 + tid; i < 4 * 257; i += G * 512) {
            const int h = i / 257, d = i % 257 - 128, rel = -d, n = rel < 0 ? -rel : rel;
            int bucket = rel > 0 ? 16 : 0;
            if (n < 8) bucket += n; else { int large = 8 + (31 - __clz(n * n)) - 6; if (large > 15) large = 15; bucket += large; }
            tbl[i] = t5[bucket * 4 + h];
          } }
        { const float* x = IN_PTR(0); float* out = OUT_PTR(); bf16* HB = (bf16*)(ws + WS_HB); const float* g = IN_PTR(2); const float* b = IN_PTR(3);
          for (int m = gw; m < T; m += NGW) ln_row(x + (size_t)m * D, out + (size_t)m * D, HB + (size_t)m * D, g, b, lane); }
        __syncthreads();
        {
            const float* mem = IN_PTR(1); const float* w_mem = IN_PTR(12);
            LAS float* As = (LAS float*)(lds + RING_OFF); LAS float* Bs = As + 16 * 129;
            for (int it = bx; it < 256; it += G) { const int l = it >> 7, tt = it & 127;
                memkv_tile(mem, w_mem + (size_t)l * D * 512, (bf16*)(ws + WS_KM) + (size_t)l * NB * NMEM * 256, (bf16*)(ws + WS_VM) + (size_t)l * NB * NMEM * 256, tt >> 3, tt & 7, As, Bs, tid); }
        }
    }
    GRID_BAR();

    for (int l = 0; l < 2; ++l) {
#ifndef NO_P1
        {
            unsigned char* ws = WS_PTR();
            pg8::Gemm g{(const bf16*)(ws + WS_HB), (const bf16*)(ws + WS_WIN) + (size_t)l * DINP * D, T, DINP, D}; pg8::StaticOrder SO; SO.init(T, DINP, gridDim.x, blockIdx.x);
            pg8::EpiRoute E{(bf16*)(ws + WS_P13), (bf16*)(ws + WS_IQ), (bf16*)(ws + WS_IK), (float*)(ws + WS_IW), (const float*)(ws + WS_TBL + 65536) + l * DINP};
            pg8::gemm_phase<pg8::EpiRoute, pg8::StaticOrder, true, true>((LAS unsigned char*)lds_raw + RING_OFF, g, SO, E);
        }
#endif
        GRID_BAR();
#ifndef NO_P2
        {
            LAS unsigned char* lds = (LAS unsigned char*)lds_raw;
            int tid_ = threadIdx.x, G_ = gridDim.x, bx_ = blockIdx.x; asm volatile("" : "+v"(tid_), "+s"(G_), "+s"(bx_));
            const int tid = tid_, lane = tid & 63, wave = __builtin_amdgcn_readfirstlane(tid >> 6);
            const int G = G_, bx = bx_, vcu = (G % 8 == 0) ? (bx % 8) * (G / 8) + bx / 8 : bx;
            const int gw = vcu * NWAVES + wave, NGW = G * NWAVES;
            unsigned char* ws = WS_PTR();
            bf16* MIX = (bf16*)(ws + WS_MIX);
            const bf16* KM = (const bf16*)(ws + WS_KM) + (size_t)l * NB * NMEM * 256; const bf16* VM = (const bf16*)(ws + WS_VM) + (size_t)l * NB * NMEM * 256;
            for (int blk = bx; blk < T / 128; blk += G)
                mixer_a_unit(blk, GRP(G_AU), GRP(G_AV), GRP(G_AG), IN_PTR(6) + l * GW, IN_PTR(7) + l * GW, IN_PTR(8) + (size_t)l * 4 * 128 * 128, IN_PTR(9) + l * 4 * 128, MIX, (LAS float*)(lds + RING_OFF), tid);
            LAS float* sc = (LAS float*)(lds + RING_OFF + wave * 16384); LAS float* qs = (LAS float*)(lds + SCR_OFF + wave * 256);
            { const float* brel = IN_PTR(10) + (size_t)l * 4 * 257;
              for (int it = gw; it < T * 4; it += NGW) attn_wave<0>(it >> 2, it & 3, GRP(G_BQ), GRP(G_BK), GRP(G_BV), GRP(G_BG), MIX, 256, brel, sc, qs, nullptr, 0u, 0, lane); }
            for (int it = gw; it < T * 4; it += NGW) attn_wave<2>(it >> 2, it & 3, GRP(G_MQ), KM, VM, GRP(G_MG), MIX, 768, nullptr, sc, qs, nullptr, 0u, 0, lane);
            __syncthreads();
            for (int token = bx; token < T; token += G) mixer_c_token(token, (const bf16*)(ws + WS_IQ), (const bf16*)(ws + WS_IK), (const float*)(ws + WS_IW), GRP(G_CQ), GRP(G_CK), GRP(G_CV), GRP(G_CG), MIX, (const float*)(ws + WS_TBL), lds, tid);
        }
#endif
        GRID_BAR();
#ifndef NO_P3
        {
            unsigned char* ws = WS_PTR();
            pg8::Gemm g{(const bf16*)(ws + WS_MIX), (const bf16*)(ws + WS_WOUT) + (size_t)l * D * D, T, D, D}; pg8::StaticOrder SO; SO.init(T, D, gridDim.x, blockIdx.x);
            pg8::EpiResid E{OUT_PTR(), IN_PTR(14) + l * D};
            pg8::gemm_phase<pg8::EpiResid, pg8::StaticOrder, true, true>((LAS unsigned char*)lds_raw + RING_OFF, g, SO, E);
        }
#endif
        GRID_BAR();
        {
            int tid_ = threadIdx.x, G_ = gridDim.x, bx_ = blockIdx.x; asm volatile("" : "+v"(tid_), "+s"(G_), "+s"(bx_));
            const int tid = tid_, lane = tid & 63, wave = __builtin_amdgcn_readfirstlane(tid >> 6);
            const int G = G_, bx = bx_, vcu = (G % 8 == 0) ? (bx % 8) * (G / 8) + bx / 8 : bx;
            const int gw = vcu * NWAVES + wave, NGW = G * NWAVES;
            float* out = OUT_PTR(); bf16* HB = (bf16*)(WS_PTR() + WS_HB); const float* g = IN_PTR(15) + l * D; const float* b = IN_PTR(16) + l * D;
            for (int m = gw; m < T; m += NGW) ln_row(out + (size_t)m * D, out + (size_t)m * D, HB + (size_t)m * D, g, b, lane);
        }
        if (l == 0) GRID_BAR();
    }
}

extern "C" void kernel_launch(void* const* d_in, const int* in_sizes, int n_in, void* d_out, int out_size, void* d_ws, size_t ws_size, hipStream_t stream) {
    static int grid = 0;
    if (grid == 0) {
        if (n_in != 17 || out_size != T * D || ws_size < WS_END) { fprintf(stderr, "kernel_launch: unexpected n_in %d / out_size %d / ws_size %zu; nothing launched\n", n_in, out_size, ws_size); grid = -1; return; }
        int dev = 0, cus = 0, per_cu = 0;
        if (hipGetDevice(&dev) != hipSuccess || hipDeviceGetAttribute(&cus, hipDeviceAttributeMultiprocessorCount, dev) != hipSuccess) { grid = -1; return; }
        if (hipFuncSetAttribute((const void*)mk_fwd, hipFuncAttributeMaxDynamicSharedMemorySize, LDS_BYTES) != hipSuccess) { fprintf(stderr, "kernel_launch: hipFuncSetAttribute failed\n"); grid = -1; return; }
        if (hipOccupancyMaxActiveBlocksPerMultiprocessor(&per_cu, (const void*)mk_fwd, NWAVES * 64, LDS_BYTES) != hipSuccess || per_cu < 1) { fprintf(stderr, "kernel_launch: occupancy query says %d blocks per CU; nothing launched\n", per_cu); (void)hipGetLastError(); grid = -1; return; }
        grid = cus;
    }
    if (grid < 0) return;
    if (hipMemsetAsync((char*)d_ws + WS_CTL, 0, CTL_ZERO_BYTES, stream) != hipSuccess) { fprintf(stderr, "kernel_launch: memset failed\n"); return; }
    Args a{};
    for (int i = 0; i < 17; ++i) a.in[i] = (const float*)d_in[i];
    a.out = (float*)d_out; a.ws = (unsigned char*)d_ws;
    hipLaunchKernelGGL(mk_fwd, dim3(grid), dim3(NWAVES * 64), LDS_BYTES, stream, a);
}
```

```cpp
#include <hip/hip_runtime.h>
#include <cstdio>
#include <cstdint>
namespace pg8 {
#define PG8_LAS __attribute__((address_space(3)))
typedef unsigned short bf16_t;
typedef short bf16x8 __attribute__((ext_vector_type(8)));
typedef float f32x4 __attribute__((ext_vector_type(4)));
typedef unsigned u32x4 __attribute__((ext_vector_type(4)));
constexpr int BM = 256, BK = 64, HALF = 128, HTB = HALF * BK * 2  , STAGE_BYTES = 8 * HTB, NXCD = 8, WGM = 8;

__host__ __device__ __forceinline__ int lds_byte(int r, int c) { const int st = (r >> 4) * 2 + (c >> 5), rr = r & 15, cc = c & 31, ob = rr * 64 + cc * 2; return st * 1024 + (ob ^ (((ob >> 9) & 1) << 5)); }
__host__ __device__ __forceinline__ void stage_rc(int b, int& R, int& C) { const int st = b / 1024, sb = b % 1024, swz = sb ^ (((sb >> 9) & 1) << 5); R = (st >> 1) * 16 + swz / 64; C = (st & 1) * 32 + (swz % 64) / 2; }
__host__ __device__ __forceinline__ int perm32(int rho) { const int n = rho >> 4, i = rho & 15; return 8 * (i >> 2) + 4 * n + (i & 3); }

struct Unit { int pm, pn; };
struct Gemm { const bf16_t* A; const bf16_t* Bt; int M, N, K; };

struct StaticOrder {
    int nM, nN, nwg, G, c;
    __host__ __device__ void init(int M, int N, int G_, int c_) { nM = M / BM; nN = N / BM; nwg = nM * nN; G = G_; c = c_; }
    __host__ __device__ bool next(int i, Unit& u) const {
        const long L = (long)i * G + c; if (L >= nwg) return false;
        int wgid = (int)L; { const int q = nwg / NXCD, r = nwg % NXCD, xcd = wgid % NXCD, off = wgid / NXCD; wgid = (xcd < r ? xcd * (q + 1) : r * (q + 1) + (xcd - r) * q) + off; }
        const int nig = WGM * nN, gid = wgid / nig, fm = gid * WGM, gsz = (nM - fm) < WGM ? (nM - fm) : WGM;
        u.pm = fm + ((wgid % nig) % gsz); u.pn = (wgid % nig) / gsz; return true;
    }
    __device__ __forceinline__ void a_ready(const Unit&) const {}
    __device__ __forceinline__ void done(const Unit&) const {}
};

__device__ __forceinline__ unsigned cvt_pk_bf16(float lo, float hi) { unsigned r; asm volatile("v_cvt_pk_bf16_f32 %0, %1, %2" : "=v"(r) : "v"(lo), "v"(hi)); return r; }
typedef float f32x2 __attribute__((ext_vector_type(2)));
template <class Epi, class Sched, bool ALIGN_EPI = false, bool SP2 = false>
__device__ __forceinline__ void gemm_phase(PG8_LAS unsigned char* lds, const Gemm g, const Sched& S, const Epi& E) {
    const int tid = threadIdx.x, wid = __builtin_amdgcn_readfirstlane(tid >> 6), lane = tid & 63, wr = wid >> 2, wc = wid & 3, fr = lane & 15, fq = lane >> 4;
    const int K = g.K, nt = K / BK;
    unsigned voffA[2], voffB[2];
#pragma unroll
    for (int i = 0; i < 2; ++i) { int R, C; stage_rc(tid * 16 + i * 8192, R, C); const int Rb = Epi::PERM ? ((R & ~31) + perm32(R & 31)) : R;
        voffA[i] = (unsigned)(R * K + C) * 2u; voffB[i] = (unsigned)(Rb * K + C) * 2u; }
    const size_t kstep = (size_t)(BK * 2);
    const size_t hstep = (size_t)HALF * K * 2;
    const size_t tstep = 2 * hstep;
    const unsigned ldsw = (unsigned)wid * 1024u;
    const int aoff = lds_byte(wr * 64 + fr, fq * 8), boff = lds_byte(wc * 32 + fr, fq * 8);
#define PG8_SA(b, h) (((b) * 2 + (h)) * HTB)
#define PG8_SB(b, h) ((4 + (b) * 2 + (h)) * HTB)
#define PG8_STAGE(bufoff, gbase, voff) do { _Pragma("unroll") for (int _i = 0; _i < 2; ++_i) \
        __builtin_amdgcn_global_load_lds((const unsigned*)((const char*)(gbase) + (voff)[_i]), (PG8_LAS unsigned*)(lds + (bufoff) + ldsw + _i * 8192), 16, 0, 0); } while (0)
#define PG8_LDA(dst, b, h) do { _Pragma("unroll") for (int m = 0; m < 4; ++m) _Pragma("unroll") for (int k = 0; k < 2; ++k) dst[m][k] = *(const PG8_LAS bf16x8*)(lds + PG8_SA(b, h) + aoff + m * 2048 + k * 1024); } while (0)
#define PG8_LDB(dst, b, h) do { _Pragma("unroll") for (int n = 0; n < 2; ++n) _Pragma("unroll") for (int k = 0; k < 2; ++k) dst[n][k] = *(const PG8_LAS bf16x8*)(lds + PG8_SB(b, h) + boff + n * 2048 + k * 1024); } while (0)
#define PG8_MMA(ai, bj, At, Bt) do { __builtin_amdgcn_s_setprio(1); _Pragma("unroll") for (int m = 0; m < 4; ++m) _Pragma("unroll") for (int n = 0; n < 2; ++n) _Pragma("unroll") for (int k = 0; k < 2; ++k) \
        acc[ai][bj][m][n] = __builtin_amdgcn_mfma_f32_16x16x32_bf16(Bt[n][k], At[m][k], acc[ai][bj][m][n], 0, 0, 0); __builtin_amdgcn_s_setprio(0); } while (0)
#define PG8_WAIT_V(n) asm volatile("s_waitcnt vmcnt(" #n ")" ::: "memory")
#define PG8_WAIT_L(n) asm volatile("s_waitcnt lgkmcnt(" #n ")" ::: "memory")
#define PG8_BAR __builtin_amdgcn_s_barrier()
#define PG8_SCHED __builtin_amdgcn_sched_barrier(0)
    Unit cur, nxt; int ui = 0;
    if (!S.next(0, cur)) return;
    f32x4 acc[2][2][4][2];
#pragma unroll
    for (int a = 0; a < 2; ++a)
#pragma unroll
        for (int b = 0; b < 2; ++b)
#pragma unroll
            for (int m = 0; m < 4; ++m)
#pragma unroll
                for (int n = 0; n < 2; ++n) acc[a][b][m][n] = (f32x4){0.f, 0.f, 0.f, 0.f};
    bf16x8 At[4][2], B0[2][2], B1[2][2];
    const char* cA = (const char*)g.A + (size_t)cur.pm * tstep; const char* cB = (const char*)g.Bt + (size_t)cur.pn * tstep;
    S.a_ready(cur);
    if constexpr (SP2) {
        PG8_STAGE(PG8_SB(0, 0), cB, voffB); PG8_STAGE(PG8_SB(0, 1), cB + hstep, voffB); PG8_STAGE(PG8_SA(0, 0), cA, voffA); PG8_STAGE(PG8_SA(0, 1), cA + hstep, voffA);
        if (wr == 1) PG8_BAR;
        PG8_WAIT_V(2); PG8_BAR;
        PG8_STAGE(PG8_SB(1, 0), cB + kstep, voffB); PG8_STAGE(PG8_SA(1, 0), cA + kstep, voffA); PG8_STAGE(PG8_SB(1, 1), cB + hstep + kstep, voffB);
        PG8_WAIT_V(6); PG8_BAR;
    } else {
        PG8_STAGE(PG8_SB(0, 0), cB, voffB); PG8_STAGE(PG8_SA(0, 0), cA, voffA); PG8_STAGE(PG8_SB(0, 1), cB + hstep, voffB); PG8_STAGE(PG8_SA(0, 1), cA + hstep, voffA);
        if (wr == 1) PG8_BAR;
        PG8_WAIT_V(4); PG8_BAR;
        PG8_STAGE(PG8_SB(1, 0), cB + kstep, voffB); PG8_STAGE(PG8_SA(1, 0), cA + kstep, voffA); PG8_STAGE(PG8_SB(1, 1), cB + hstep + kstep, voffB);
        PG8_WAIT_V(6); PG8_BAR;
    }
    for (;;) {
        const bool has_next = S.next(ui + 1, nxt);
        const char* nA = has_next ? (const char*)g.A + (size_t)nxt.pm * tstep : cA; const char* nB = has_next ? (const char*)g.Bt + (size_t)nxt.pn * tstep : cB;
        for (int t = 0; t < nt; t += 2) {
            const bool last = (t == nt - 2);
            const char* a1 = cA + (size_t)(t + 1) * kstep;
            const char* a2 = last ? nA : cA + (size_t)(t + 2) * kstep; const char* b2 = last ? nB : cB + (size_t)(t + 2) * kstep;
            const char* a3 = a2 + kstep; const char* b3 = b2 + kstep;
            if (last && has_next) S.a_ready(nxt);
            if constexpr (SP2) {
            PG8_LDB(B0, 0, 0); PG8_LDB(B1, 0, 1); PG8_SCHED; PG8_LDA(At, 0, 0); PG8_STAGE(PG8_SA(1, 1), a1 + hstep, voffA);
            PG8_WAIT_V(8); PG8_WAIT_L(0); PG8_BAR; PG8_MMA(0, 0, At, B0); PG8_MMA(0, 1, At, B1); PG8_BAR; PG8_SCHED;
            PG8_LDA(At, 0, 1); PG8_STAGE(PG8_SB(0, 0), b2, voffB); PG8_STAGE(PG8_SB(0, 1), b2 + hstep, voffB); PG8_STAGE(PG8_SA(0, 0), a2, voffA);
            PG8_WAIT_V(8); PG8_WAIT_L(0); PG8_BAR; PG8_MMA(1, 0, At, B0); PG8_MMA(1, 1, At, B1); PG8_BAR; PG8_SCHED;
            PG8_LDB(B0, 1, 0); PG8_LDB(B1, 1, 1); PG8_SCHED; PG8_LDA(At, 1, 0); PG8_STAGE(PG8_SA(0, 1), a2 + hstep, voffA);
            PG8_WAIT_V(8); PG8_WAIT_L(0); PG8_BAR; PG8_MMA(0, 0, At, B0); PG8_MMA(0, 1, At, B1); PG8_BAR; PG8_SCHED;
            PG8_LDA(At, 1, 1); PG8_STAGE(PG8_SB(1, 0), b3, voffB); PG8_STAGE(PG8_SB(1, 1), b3 + hstep, voffB); PG8_STAGE(PG8_SA(1, 0), a3, voffA);
            PG8_WAIT_V(8); PG8_WAIT_L(0); PG8_BAR; PG8_MMA(1, 0, At, B0); PG8_MMA(1, 1, At, B1); PG8_BAR; PG8_SCHED;
            } else {
            PG8_LDB(B0, 0, 0); PG8_SCHED; PG8_LDA(At, 0, 0); PG8_STAGE(PG8_SA(1, 1), a1 + hstep, voffA);
            PG8_WAIT_L(8); PG8_BAR; PG8_WAIT_L(0); PG8_MMA(0, 0, At, B0); PG8_BAR; PG8_SCHED;
            PG8_LDB(B1, 0, 1); PG8_STAGE(PG8_SB(0, 0), b2, voffB);
            PG8_BAR; PG8_WAIT_L(0); PG8_MMA(0, 1, At, B1); PG8_BAR;
            PG8_LDA(At, 0, 1); PG8_STAGE(PG8_SA(0, 0), a2, voffA);
            PG8_BAR; PG8_WAIT_L(0); PG8_MMA(1, 0, At, B0); PG8_BAR; PG8_SCHED;
            PG8_STAGE(PG8_SB(0, 1), b2 + hstep, voffB);
            PG8_WAIT_V(6); PG8_BAR; PG8_MMA(1, 1, At, B1); PG8_BAR;
            PG8_LDB(B0, 1, 0); PG8_SCHED; PG8_LDA(At, 1, 0); PG8_STAGE(PG8_SA(0, 1), a2 + hstep, voffA);
            PG8_WAIT_L(8); PG8_BAR; PG8_WAIT_L(0); PG8_MMA(0, 0, At, B0); PG8_BAR; PG8_SCHED;
            PG8_LDB(B1, 1, 1); PG8_STAGE(PG8_SB(1, 0), b3, voffB);
            PG8_BAR; PG8_WAIT_L(0); PG8_MMA(0, 1, At, B1); PG8_BAR;
            PG8_LDA(At, 1, 1); PG8_STAGE(PG8_SA(1, 0), a3, voffA);
            PG8_BAR; PG8_WAIT_L(0); PG8_MMA(1, 0, At, B0); PG8_BAR; PG8_SCHED;
            PG8_STAGE(PG8_SB(1, 1), b3 + hstep, voffB);
            PG8_WAIT_V(6); PG8_BAR; PG8_MMA(1, 1, At, B1); PG8_BAR;
            }
        }
        if constexpr (ALIGN_EPI) { if (wr == 0) PG8_BAR; }
        if constexpr (!Epi::AFTER_DRAIN) { E(acc, cur, wr, wc, fr, fq); S.done(cur); }
        if (!has_next) break;
#pragma unroll
        for (int a = 0; a < 2; ++a)
#pragma unroll
            for (int b = 0; b < 2; ++b)
#pragma unroll
                for (int m = 0; m < 4; ++m)
#pragma unroll
                    for (int n = 0; n < 2; ++n) acc[a][b][m][n] = (f32x4){0.f, 0.f, 0.f, 0.f};
        cur = nxt; cA = nA; cB = nB; ++ui;
        if constexpr (ALIGN_EPI) { if (wr == 1) PG8_BAR; }
    }
    PG8_WAIT_V(0);
    if constexpr (!ALIGN_EPI) { if (wr == 0) PG8_BAR; }
    PG8_BAR;
    if constexpr (Epi::AFTER_DRAIN) { E.fused(acc, cur, wr, wc, fr, fq, lds, wid, lane); S.done(cur); }
#undef PG8_SA
#undef PG8_SB
#undef PG8_STAGE
#undef PG8_LDA
#undef PG8_LDB
#undef PG8_MMA
#undef PG8_WAIT_V
#undef PG8_WAIT_L
#undef PG8_BAR
#undef PG8_SCHED
}
}
typedef unsigned short bf16;
constexpr int NB = 8, S = 4096, D = 1024, T = NB * S, GW = 256, DIN = 3912, DINP = 4096, NMEM = 256;
constexpr float LN_EPS = 1e-5f;
constexpr float ALPHA = 1.41421356237309515f;
constexpr size_t MiB = 1u << 20;
constexpr size_t WS_CTL = 0, CTL_ZERO_BYTES = 1 * MiB;
constexpr size_t WS_WIN = 2 * MiB;
constexpr size_t WS_WOUT = 18 * MiB;
constexpr size_t WS_TBL = 22 * MiB;
constexpr size_t WS_KM = 24 * MiB;
constexpr size_t WS_VM = 26 * MiB;
constexpr size_t WS_HB = 32 * MiB;
constexpr size_t WS_MIX = 96 * MiB;
constexpr size_t WS_P13 = 160 * MiB;
constexpr size_t WS_IQ = 368 * MiB;
constexpr size_t WS_IK = 400 * MiB;
constexpr size_t WS_IW = 404 * MiB;
constexpr size_t WS_END = 406 * MiB;
enum Grp { G_AU = 0, G_AV, G_AG, G_BQ, G_BK, G_BV, G_BG, G_CQ, G_CK, G_CV, G_CG, G_MQ, G_MG };
constexpr int CW_BAR = 4096;

__device__ __forceinline__ float bf2f(bf16 v) { return __uint_as_float((unsigned)v << 16); }
__device__ __forceinline__ bf16 f2bf(float f) { unsigned u = __float_as_uint(f); return (bf16)((u + 0x7fffu + ((u >> 16) & 1u)) >> 16); }
__device__ __forceinline__ float fast_sigmoid(float x) { return __builtin_amdgcn_rcpf(1.f + __builtin_amdgcn_exp2f(-1.4426950408889634f * x)); }
__device__ __forceinline__ float gelu_tanh(float x) { const float u = 0.7978845608028654f * (x + 0.044715f * x * x * x); return x * fast_sigmoid(2.f * u); }
__device__ __forceinline__ float silu(float x) { return x * fast_sigmoid(x); }
__device__ __forceinline__ float wave_sum(float v) {
#pragma unroll
    for (int o = 1; o < 64; o <<= 1) v += __shfl_xor(v, o);
    return v;
}
__device__ __forceinline__ float wave_max(float v) {
#pragma unroll
    for (int o = 1; o < 64; o <<= 1) v = fmaxf(v, __shfl_xor(v, o));
    return v;
}
__host__ __device__ __forceinline__ int perm_col(int col) {
    if (col < 3328) return col;
    if (col < 3392) return 3840 + (col - 3328);
    if (col < 3400) return 3904 + (col - 3392);
    if (col < 3656) return 3328 + (col - 3400);
    return 3584 + (col - 3656);
}

namespace pg8 {
__device__ __forceinline__ f32x4 act4(f32x4 v, int mode) {
    if (mode == 1) { v[0] = gelu_tanh(v[0]); v[1] = gelu_tanh(v[1]); v[2] = gelu_tanh(v[2]); v[3] = gelu_tanh(v[3]); }
    else if (mode == 2) { v[0] = silu(v[0]); v[1] = silu(v[1]); v[2] = silu(v[2]); v[3] = silu(v[3]); }
    else if (mode == 3) { v = v * 0.125f; }
    else if (mode == 4) { v = v * (0.125f * 1.4426950408889634f); }
    return v;
}
struct EpiRoute {
    static constexpr bool PERM = true, AFTER_DRAIN = false;
    bf16_t* p13; bf16_t* iq; bf16_t* ik; float* iw; const float* bias;
    __device__ __forceinline__ void operator()(const f32x4 (&acc)[2][2][4][2], const Unit& u, int wr, int wc, int fr, int fq) const {
        const int pn = u.pn, row0 = u.pm * BM + wr * 64 + fr, cl0 = wc * 32 + 8 * fq;
        f32x4 bv[2][2];
#pragma unroll
        for (int bj = 0; bj < 2; ++bj)
#pragma unroll
            for (int n = 0; n < 2; ++n) bv[bj][n] = *(const f32x4*)(bias + pn * BM + bj * HALF + cl0 + 4 * n);
        if (pn == 15) {
#pragma unroll
            for (int ai = 0; ai < 2; ++ai)
#pragma unroll
                for (int m = 0; m < 4; ++m) { const size_t row = (size_t)(row0 + ai * HALF + m * 16);
                    const f32x4 v0 = acc[ai][0][m][0] + bv[0][0], v1 = acc[ai][0][m][1] + bv[0][1];
                    if (wc < 2) { u32x4 w; w.x = cvt_pk_bf16(v0[0], v0[1]); w.y = cvt_pk_bf16(v0[2], v0[3]); w.z = cvt_pk_bf16(v1[0], v1[1]); w.w = cvt_pk_bf16(v1[2], v1[3]); *(u32x4*)(ik + row * 64 + cl0) = w; }
                    else if (wc == 2 && fq == 0) { *(f32x4*)(iw + row * 8) = v0; *(f32x4*)(iw + row * 8 + 4) = v1; } }
            return;
        }
        bf16_t* base; int ldc, mode;
        if (pn <= 10) { base = p13 + (size_t)pn * T * GW; ldc = GW; mode = (pn == G_AU || pn == G_AV) ? 1 : (pn == G_AG || pn == G_BG || pn == G_CG) ? 2 : (pn == G_BQ) ? 4 : (pn == G_CQ) ? 3 : 0; }
        else if (pn <= 12) { base = iq + (pn - 11) * 256; ldc = 512; mode = 0; }
        else if (pn == 13) { base = p13 + (size_t)G_MQ * T * GW; ldc = GW; mode = 4; }
        else { base = p13 + (size_t)G_MG * T * GW; ldc = GW; mode = 2; }
#pragma unroll
        for (int ai = 0; ai < 2; ++ai)
#pragma unroll
            for (int m = 0; m < 4; ++m) { bf16_t* rowp = base + (size_t)(row0 + ai * HALF + m * 16) * ldc + cl0;
#pragma unroll
                for (int bj = 0; bj < 2; ++bj) { const f32x4 v0 = act4(acc[ai][bj][m][0] + bv[bj][0], mode), v1 = act4(acc[ai][bj][m][1] + bv[bj][1], mode);
                    u32x4 w; w.x = cvt_pk_bf16(v0[0], v0[1]); w.y = cvt_pk_bf16(v0[2], v0[3]); w.z = cvt_pk_bf16(v1[0], v1[1]); w.w = cvt_pk_bf16(v1[2], v1[3]);
                    *(u32x4*)(rowp + bj * HALF) = w; } }
    }
};
struct EpiResid {
    static constexpr bool PERM = false, AFTER_DRAIN = false;
    float* out; const float* bias;
    __device__ __forceinline__ void operator()(const f32x4 (&acc)[2][2][4][2], const Unit& u, int wr, int wc, int fr, int fq) const {
        const int col0 = u.pn * BM + wc * 32 + 4 * fq;
#pragma unroll
        for (int ai = 0; ai < 2; ++ai)
#pragma unroll
            for (int m = 0; m < 4; ++m) { float* rowp = out + (size_t)(u.pm * BM + ai * HALF + wr * 64 + m * 16 + fr) * D + col0;
#pragma unroll
                for (int bj = 0; bj < 2; ++bj)
#pragma unroll
                    for (int n = 0; n < 2; ++n) { float* p = rowp + bj * HALF + n * 16; const f32x4 bv = *(const f32x4*)(bias + col0 + bj * HALF + n * 16);
                        const f32x4 h = *(const f32x4*)p; *(f32x4*)p = h * ALPHA + acc[ai][bj][m][n] + bv; } }
    }
};
}
#define GAS __attribute__((address_space(1)))
#define LAS __attribute__((address_space(3)))
typedef unsigned short bf16;
typedef unsigned v4u __attribute__((ext_vector_type(4)));
typedef float f32x4 __attribute__((ext_vector_type(4)));
typedef short bf16x8 __attribute__((ext_vector_type(8)));
typedef GAS unsigned gu32;
typedef GAS unsigned long long gu64;
#define RLX_AGENT __ATOMIC_RELAXED, __HIP_MEMORY_SCOPE_AGENT
#define LDS_WAIT() asm volatile("s_waitcnt lgkmcnt(0)" ::: "memory")
#define VM_WAIT() asm volatile("s_waitcnt vmcnt(0)" ::: "memory")
__device__ __forceinline__ unsigned long long rt() { return __builtin_amdgcn_s_memrealtime(); }
__device__ __forceinline__ unsigned pk2(float lo, float hi) { return (unsigned)f2bf(lo) | ((unsigned)f2bf(hi) << 16); }

#define XB_TMO      128
#define XB_XCNT(j)  (256  + 64 * (j))
#define XB_XSUB(j)  (1280 + 64 * (j))
#define XB_XGEN(j)  (2304 + 64 * (j))
#define XB_TOP      3328
#define XB_TOPGEN   3392
#define XCD_BAR_WORDS 3456
#define XB_SPIN_CAP (1u << 18)

__device__ __forceinline__ unsigned xb_ld(unsigned* p)              { return __hip_atomic_load(p, __ATOMIC_RELAXED, __HIP_MEMORY_SCOPE_AGENT); }
__device__ __forceinline__ unsigned xb_add(unsigned* p, unsigned v) { return __hip_atomic_fetch_add(p, v, __ATOMIC_RELAXED, __HIP_MEMORY_SCOPE_AGENT); }
__device__ __forceinline__ unsigned xb_xcc_id() { return (unsigned)__builtin_amdgcn_s_getreg((3 << 11) | 20) & 0xFu; }
#define XB_SPIN(cond, bar) do { unsigned _sp = 0; while (cond) { __builtin_amdgcn_s_sleep(1); \
    if ((++_sp & 255u) == 0u) { if (xb_ld(&(bar)[XB_TMO])) break; if (_sp > XB_SPIN_CAP) { atomicAdd(&(bar)[XB_TMO], 1u); break; } } } } while (0)

struct XcdBarrier {
    unsigned* bar; unsigned x;
    volatile LAS unsigned* st;
};

__device__ __forceinline__ XcdBarrier xcd_barrier_post(unsigned* bar, volatile LAS unsigned* st) {
    XcdBarrier b; b.bar = bar; b.x = xb_xcc_id(); b.st = st;
    if (threadIdx.x == 0) (void)xb_add(&bar[XB_XCNT(b.x)], 1u);
    return b;
}
__device__ __forceinline__ void xcd_barrier_complete(unsigned* bar, unsigned x, unsigned& nloc, unsigned& nx) {
    const unsigned G = gridDim.x * gridDim.y * gridDim.z;
    unsigned sum, cnt, mine, sp = 0u;
    for (;;) {
        sum = 0u; cnt = 0u; mine = 0u;
#pragma unroll
        for (unsigned j = 0; j < 16; ++j) { const unsigned c = xb_ld(&bar[XB_XCNT(j)]); sum += c; cnt += (c > 0u) ? 1u : 0u; mine = (j == x) ? c : mine; }
        if (sum == G) break;
        __builtin_amdgcn_s_sleep(1);
        if ((++sp & 255u) == 0u) { if (xb_ld(&bar[XB_TMO])) break; if (sp > XB_SPIN_CAP) { atomicAdd(&bar[XB_TMO], 1u); break; } }
    }
    nloc = mine > 0u ? mine : 1u; nx = cnt > 0u ? cnt : 1u;
}

__device__ __forceinline__ void xcd_barrier(const XcdBarrier& b) {
    asm volatile("s_waitcnt vmcnt(0)" ::: "memory");
    __syncthreads();
    if (threadIdx.x == 0) {
        unsigned* bar = b.bar;
        __builtin_amdgcn_s_waitcnt(0);
        unsigned nloc = b.st[0], nx = b.st[1];
        if (nloc == 0u) { xcd_barrier_complete(bar, b.x, nloc, nx); b.st[0] = nloc; b.st[1] = nx; }
        const unsigned old = xb_add(&bar[XB_XSUB(b.x)], 1u);
        const unsigned gen = old / nloc;
        if (old + 1u == (gen + 1u) * nloc) {
            __builtin_amdgcn_fence(__ATOMIC_RELEASE, "agent");
            asm volatile("s_waitcnt vmcnt(0)" ::: "memory");
            const unsigned og = xb_add(&bar[XB_TOP], 1u);
            const unsigned tg = og / nx;
            if (og + 1u == (tg + 1u) * nx) xb_add(&bar[XB_TOPGEN], 1u);
            else XB_SPIN(xb_ld(&bar[XB_TOPGEN]) == tg, bar);
            __builtin_amdgcn_fence(__ATOMIC_ACQUIRE, "agent");
            xb_add(&bar[XB_XGEN(b.x)], 1u);
            asm volatile("s_waitcnt vmcnt(0)" ::: "memory");
        } else {
            XB_SPIN(xb_ld(&bar[XB_XGEN(b.x)]) == gen, bar);
            __builtin_amdgcn_fence(__ATOMIC_ACQUIRE, "agent");
            asm volatile("s_waitcnt vmcnt(0)" ::: "memory");
        }
    }
    __syncthreads();
}
namespace att {
typedef short bf16x8 __attribute__((ext_vector_type(8)));
typedef short s16x4 __attribute__((ext_vector_type(4)));
typedef float f32x16 __attribute__((ext_vector_type(16)));
typedef float f32x2_t __attribute__((ext_vector_type(2)));
typedef __bf16 bf16x2_t __attribute__((ext_vector_type(2)));
typedef unsigned u32x4 __attribute__((ext_vector_type(4)));
typedef unsigned u32x2 __attribute__((ext_vector_type(2)));
constexpr int L_K = 0, L_V = 32768, L_OST = 65536, L_BM = 98304, BM_STRIDE = 130  , L_BIAS = L_BM + 64 * BM_STRIDE * 4  , L_WS = L_BIAS + 4352  , L_END = L_WS + 8 * 256;
constexpr float LOG2E = 1.4426950408889634f;
__device__ __forceinline__ int crow(int r, int hi) { return (r & 3) + 8 * (r >> 2) + 4 * hi; }
__device__ __forceinline__ unsigned cvtpk(float lo, float hi) { f32x2_t v = {lo, hi}; bf16x2_t b = __builtin_convertvector(v, bf16x2_t); return __builtin_bit_cast(unsigned, b); }
__device__ __forceinline__ s16x4 vtr(const LAS unsigned char* p) { typedef short v4i16_t __attribute__((ext_vector_type(4))); return __builtin_bit_cast(s16x4, __builtin_amdgcn_ds_read_tr16_b64_v4i16((LAS v4i16_t*)p)); }

__device__ __forceinline__ void fill_bias(LAS unsigned char* lds, const float* tbl, int tid) {
    LAS float* bl = (LAS float*)(lds + L_BIAS);
    for (int i = tid; i < 4 * 257; i += 512) { const int h = i / 257; bl[i] = (tbl[i] - tbl[h * 257 + 256]) * LOG2E; }
}

struct Cfg { const bf16* Q; const bf16* K; const bf16* V; const bf16* Gt; bf16* mix; int colofs; };

template <int MODE>
__device__ __forceinline__ void unit(LAS unsigned char* lds, const Cfg& A, int tok0, size_t kvrow0, int ntiles, int delta0, int tid) {
    const int lane = tid & 63, wave = __builtin_amdgcn_readfirstlane(tid >> 6), h = wave >> 1, qh = wave & 1, r32 = lane & 31, hi = lane >> 5;
    const int qloc = 32 * qh + r32;
    bf16x8 qr[4];
    { const bf16* qp = A.Q + (size_t)(tok0 + qloc) * GW + h * 64 + 8 * hi;
#pragma unroll
      for (int d0 = 0; d0 < 4; ++d0) qr[d0] = *(const bf16x8*)(qp + 16 * d0); }
    const int k0 = tid >> 5, rem = tid & 31, sh = rem >> 3, ch = rem & 7;
    const unsigned kw = L_K + sh * 8192 + ch * 1024 + ((k0 ^ ch) << 4);
    const unsigned vw = L_V + sh * 8192 + (ch >> 2) * 4096 + (k0 >> 3) * 512 + (k0 & 7) * 64 + (ch & 3) * 16;
    const bf16* kg = A.K + (kvrow0 + k0) * GW + rem * 8;
    const bf16* vg = A.V + (kvrow0 + k0) * GW + rem * 8;
    u32x4 kreg[4], vreg[4];
#pragma unroll
    for (int i = 0; i < 4; ++i) { kreg[i] = *(const u32x4*)(kg + (size_t)(16 * i) * GW); vreg[i] = *(const u32x4*)(vg + (size_t)(16 * i) * GW); }
    const LAS unsigned char* kb = lds + L_K + h * 8192 + hi * 1024;
    const LAS unsigned char* vb = lds + L_V + h * 8192 + ((lane >> 4) & 1) * 32 + (lane & 3) * 8 + (4 * hi + ((lane & 15) >> 2)) * 64;
    LAS float* wsf = (LAS float*)(lds + L_WS + wave * 256);
    const LAS float* biasL = (const LAS float*)(lds + L_BIAS) + h * 257;
    const LAS unsigned* bmrow = (const LAS unsigned*)(lds + L_BM) + qloc * BM_STRIDE;
    f32x16 o0 = {}, o1 = {};
    float mrun = -INFINITY, lsum = 0.f;
    for (int t = 0; t < ntiles; ++t) {
        __syncthreads();
#pragma unroll
        for (int i = 0; i < 4; ++i) { *(LAS u32x4*)(lds + kw + 256 * i) = kreg[i]; *(LAS u32x4*)(lds + vw + 1024 * i) = vreg[i]; }
        __syncthreads();
        if (t + 1 < ntiles) {
#pragma unroll
            for (int i = 0; i < 4; ++i) { kreg[i] = *(const u32x4*)(kg + (size_t)((t + 1) * 64 + 16 * i) * GW); vreg[i] = *(const u32x4*)(vg + (size_t)((t + 1) * 64 + 16 * i) * GW); }
        }
        f32x16 p0 = {}, p1 = {};
#pragma unroll
        for (int d0 = 0; d0 < 4; ++d0) {
            const int chunk = 2 * d0 + hi;
            const LAS unsigned char* kp = kb + d0 * 2048 + ((r32 ^ chunk) << 4);
            const bf16x8 a0 = *(const LAS bf16x8*)kp, a1 = *(const LAS bf16x8*)(kp + 512);
            p0 = __builtin_amdgcn_mfma_f32_32x32x16_bf16(a0, qr[d0], p0, 0, 0, 0);
            p1 = __builtin_amdgcn_mfma_f32_32x32x16_bf16(a1, qr[d0], p1, 0, 0, 0);
        }
        if (MODE != 2) {
            const int dl = delta0 - 64 * t;
            if (dl < 192) {
                const int base = dl + qloc + 128;
#pragma unroll
                for (int r = 0; r < 16; ++r) { const int kl = crow(r, hi); int i0 = base - kl, i1 = base - kl - 32; i0 = i0 > 256 ? 256 : i0; i1 = i1 > 256 ? 256 : i1; p0[r] += biasL[i0]; p1[r] += biasL[i1]; }
            }
        }
        float mloc = fmaxf(p0[0], p1[0]);
#pragma unroll
        for (int r = 1; r < 16; ++r) mloc = fmaxf(mloc, fmaxf(p0[r], p1[r]));
        mloc = fmaxf(mloc, __shfl_xor(mloc, 32));
        const float mnew = fmaxf(mrun, mloc);
        const bool grew = mnew > mrun;
        const float alpha = __builtin_amdgcn_exp2f(mrun - mnew);
        mrun = mnew;
#pragma unroll
        for (int r = 0; r < 16; ++r) { p0[r] = __builtin_amdgcn_exp2f(p0[r] - mnew); p1[r] = __builtin_amdgcn_exp2f(p1[r] - mnew); }
        if (MODE == 1) {
            const u32x2 w = *(const LAS u32x2*)(bmrow + 2 * t);
            const unsigned w0 = w.x >> (4 * hi), w1 = w.y >> (4 * hi);
#pragma unroll
            for (int r = 0; r < 16; ++r) { const int bit = (r & 3) + 8 * (r >> 2);
                p0[r] = __uint_as_float(__float_as_uint(p0[r]) & (unsigned)__builtin_amdgcn_sbfe((int)w0, bit, 1));
                p1[r] = __uint_as_float(__float_as_uint(p1[r]) & (unsigned)__builtin_amdgcn_sbfe((int)w1, bit, 1)); }
        }
        float ps = 0.f;
#pragma unroll
        for (int r = 0; r < 16; ++r) ps += p0[r] + p1[r];
        lsum = lsum * alpha + ps;
        if (__any(grew)) {
            if (hi == 0) wsf[r32] = alpha;
            asm volatile("s_waitcnt lgkmcnt(0)" ::: "memory");
#pragma unroll
            for (int g = 0; g < 4; ++g) { const f32x4 a = *(const LAS f32x4*)(wsf + 8 * g + 4 * hi);
#pragma unroll
                for (int j = 0; j < 4; ++j) { o0[4 * g + j] *= a[j]; o1[4 * g + j] *= a[j]; } }
        }
        u32x4 pw[4];
        pw[0] = (u32x4){cvtpk(p0[0], p0[1]), cvtpk(p0[2], p0[3]), cvtpk(p0[4], p0[5]), cvtpk(p0[6], p0[7])};
        pw[1] = (u32x4){cvtpk(p0[8], p0[9]), cvtpk(p0[10], p0[11]), cvtpk(p0[12], p0[13]), cvtpk(p0[14], p0[15])};
        pw[2] = (u32x4){cvtpk(p1[0], p1[1]), cvtpk(p1[2], p1[3]), cvtpk(p1[4], p1[5]), cvtpk(p1[6], p1[7])};
        pw[3] = (u32x4){cvtpk(p1[8], p1[9]), cvtpk(p1[10], p1[11]), cvtpk(p1[12], p1[13]), cvtpk(p1[14], p1[15])};
#pragma unroll
        for (int ks = 0; ks < 4; ++ks) {
            const bf16x8 pa = __builtin_bit_cast(bf16x8, pw[ks]);
            const s16x4 l0 = vtr(vb + ks * 1024), h0 = vtr(vb + ks * 1024 + 512), l1 = vtr(vb + 4096 + ks * 1024), h1 = vtr(vb + 4096 + ks * 1024 + 512);
            const bf16x8 v0 = (bf16x8){l0[0], l0[1], l0[2], l0[3], h0[0], h0[1], h0[2], h0[3]}, v1 = (bf16x8){l1[0], l1[1], l1[2], l1[3], h1[0], h1[1], h1[2], h1[3]};
            o0 = __builtin_amdgcn_mfma_f32_32x32x16_bf16(pa, v0, o0, 0, 0, 0);
            o1 = __builtin_amdgcn_mfma_f32_32x32x16_bf16(pa, v1, o1, 0, 0, 0);
        }
    }
    lsum += __shfl_xor(lsum, 32);
    if (hi == 0) wsf[r32] = __builtin_amdgcn_rcpf(lsum);
    asm volatile("s_waitcnt lgkmcnt(0)" ::: "memory");
    LAS bf16* stg = (LAS bf16*)(lds + L_OST + wave * 4096);
#pragma unroll
    for (int g = 0; g < 4; ++g) { const f32x4 a = *(const LAS f32x4*)(wsf + 8 * g + 4 * hi);
#pragma unroll
        for (int j = 0; j < 4; ++j) { const int q = 8 * g + 4 * hi + j; stg[q * 64 + r32] = f2bf(o0[4 * g + j] * a[j]); stg[q * 64 + 32 + r32] = f2bf(o1[4 * g + j] * a[j]); } }
    asm volatile("s_waitcnt lgkmcnt(0)" ::: "memory");
#pragma unroll
    for (int i = 0; i < 4; ++i) {
        const int row = i * 8 + (lane >> 3), c8 = lane & 7;
        const u32x4 ov = *(const LAS u32x4*)(stg + row * 64 + c8 * 8);
        const size_t tok = (size_t)(tok0 + 32 * qh + row);
        const u32x4 gv = *(const u32x4*)(A.Gt + tok * GW + h * 64 + c8 * 8);
        u32x4 res;
#pragma unroll
        for (int e = 0; e < 4; ++e) { const float a0 = __uint_as_float(ov[e] << 16) * __uint_as_float(gv[e] << 16), a1 = __uint_as_float(ov[e] & 0xffff0000u) * __uint_as_float(gv[e] & 0xffff0000u); res[e] = cvtpk(a0, a1); }
        *(u32x4*)(A.mix + tok * D + A.colofs + h * 64 + c8 * 8) = res;
    }
}
}
constexpr int RING_OFF = 0, RING_BYTES = 131072;
constexpr int LDSCTL_OFF = 147456 - 1024, MISC_OFF = LDSCTL_OFF + 320;
constexpr int SCR_OFF = 138240;
constexpr int LDS_BYTES = 147456;
constexpr int NWAVES = 8;

struct Args { const float* in[17]; float* out; unsigned char* ws; };

__device__ __forceinline__ void transpose_item(const float* W, int N, bf16* WT, bool perm, LAS float* scr, int item, int lane) {
    const int nblk = (N + 31) / 32, kb = item / nblk, nb = item % nblk, k0 = 64 * kb, n0 = 32 * nb;
    const bool nok = n0 + (lane & 31) < N;
#pragma unroll 8
    for (int i = 0; i < 32; ++i) { const int kk = 2 * i + (lane >> 5); scr[kk * 33 + (lane & 31)] = nok ? W[(size_t)(k0 + kk) * N + n0 + (lane & 31)] : 0.f; }
    asm volatile("s_waitcnt lgkmcnt(0)" ::: "memory");
    const int c = lane & 7;
#pragma unroll
    for (int j = 0; j < 4; ++j) { const int n = (lane >> 3) + 8 * j; const LAS float* s = scr + (8 * c) * 33 + n;
        if (n0 + n < N) {
            v4u o; o.x = pk2(s[0 * 33], s[1 * 33]); o.y = pk2(s[2 * 33], s[3 * 33]); o.z = pk2(s[4 * 33], s[5 * 33]); o.w = pk2(s[6 * 33], s[7 * 33]);
            const int drow = perm ? perm_col(n0 + n) : (n0 + n);
            *(GAS v4u*)(WT + (size_t)drow * 1024 + k0 + 8 * c) = o; } }
    asm volatile("s_waitcnt lgkmcnt(0)" ::: "memory");
}
__device__ __forceinline__ void ln_row(const float* in, float* out, bf16* outb, const float* g, const float* b, int lane) {
    const f32x4* xr = (const f32x4*)in + lane;
    f32x4 v[4]; float s = 0.f;
#pragma unroll
    for (int j = 0; j < 4; ++j) { v[j] = xr[64 * j]; s += (v[j].x + v[j].y) + (v[j].z + v[j].w); }
    const float mean = wave_sum(s) * (1.f / D); float s2 = 0.f;
#pragma unroll
    for (int j = 0; j < 4; ++j) { v[j] = v[j] - mean; s2 += (v[j].x * v[j].x + v[j].y * v[j].y) + (v[j].z * v[j].z + v[j].w * v[j].w); }
    const float rstd = rsqrtf(wave_sum(s2) * (1.f / D) + LN_EPS);
#pragma unroll
    for (int j = 0; j < 4; ++j) {
        const int c = 4 * (lane + 64 * j);
        const f32x4 o = v[j] * rstd * *(const f32x4*)(g + c) + *(const f32x4*)(b + c);
        *(f32x4*)(out + c) = o;
        *(unsigned long long*)(outb + c) = (unsigned long long)pk2(o.x, o.y) | ((unsigned long long)pk2(o.z, o.w) << 32);
    }
}
__device__ __forceinline__ void memkv_tile(const float* A, const float* W, bf16* km, bf16* vm, int tm, int tn, LAS float* As, LAS float* Bs, int tid) {
    const int tx = tid & 15, ty = tid >> 4, m0 = tm * 128, n0 = tn * 64;
    float acc[4][4];
#pragma unroll
    for (int i = 0; i < 4; ++i)
#pragma unroll
        for (int j = 0; j < 4; ++j) acc[i][j] = 0.f;
    for (int k0 = 0; k0 < D; k0 += 16) {
#pragma unroll
        for (int i = 0; i < 4; ++i) { const int e = tid + 512 * i, r = e >> 4, kk = e & 15; As[kk * 129 + r] = A[(size_t)(m0 + r) * D + k0 + kk]; }
#pragma unroll
        for (int i = 0; i < 2; ++i) { const int e = tid + 512 * i, kk = e >> 6, c = e & 63; Bs[kk * 65 + c] = W[(size_t)(k0 + kk) * 512 + n0 + c]; }
        __syncthreads();
#pragma unroll
        for (int kk = 0; kk < 16; ++kk) {
            float a[4], b[4];
#pragma unroll
            for (int i = 0; i < 4; ++i) { a[i] = As[kk * 129 + ty * 4 + i]; b[i] = Bs[kk * 65 + tx * 4 + i]; }
#pragma unroll
            for (int i = 0; i < 4; ++i)
#pragma unroll
                for (int j = 0; j < 4; ++j) acc[i][j] += a[i] * b[j];
        }
        __syncthreads();
    }
#pragma unroll
    for (int i = 0; i < 4; ++i)
#pragma unroll
        for (int j = 0; j < 4; ++j) { const int row = m0 + ty * 4 + i, col = n0 + tx * 4 + j;
            if (col < 256) km[(size_t)row * 256 + col] = f2bf(acc[i][j]); else vm[(size_t)row * 256 + col - 256] = f2bf(acc[i][j]); }
}

__device__ __forceinline__ void mixer_a_unit(int blk, const bf16* au, const bf16* av, const bf16* ag, const float* lng, const float* lnb, const float* ws_, const float* bs, bf16* mix, LAS float* vt, int tid) {
    const int wave = tid >> 6, lane = tid & 63;
    const size_t row0 = (size_t)blk * 128;
    for (int r = wave; r < 128; r += NWAVES) {
        const bf16* p = av + (row0 + r) * GW + lane * 4;
        float v[4]; float s = 0.f;
#pragma unroll
        for (int j = 0; j < 4; ++j) { v[j] = bf2f(p[j]); s += v[j]; }
        const float mean = wave_sum(s) * (1.f / GW); float s2 = 0.f;
#pragma unroll
        for (int j = 0; j < 4; ++j) { v[j] -= mean; s2 += v[j] * v[j]; }
        const float rstd = rsqrtf(wave_sum(s2) * (1.f / GW) + LN_EPS);
#pragma unroll
        for (int j = 0; j < 4; ++j) vt[r * 256 + lane * 4 + j] = bf2f(f2bf(v[j] * rstd * lng[lane * 4 + j] + lnb[lane * 4 + j]));
    }
    __syncthreads();
    const int ch = tid & 255, g = ch >> 6;
    for (int i = tid >> 8; i < 128; i += 2) {
        const float* wr = ws_ + ((size_t)g * 128 + i) * 128;
        const int jmax = i < 64 ? 64 : 128;
        float acc = 0.f;
        for (int j = 0; j < jmax; ++j) acc += wr[j] * vt[j * 256 + ch];
        acc += bs[g * 128 + i];
        const size_t idx = (row0 + i) * GW + ch;
        mix[(row0 + i) * D + ch] = f2bf(bf2f(au[idx]) * acc * bf2f(ag[idx]));
    }
    __syncthreads();
}
template <int MODE>
__device__ __forceinline__ void attn_wave(int token, int h, const bf16* Q, const bf16* K, const bf16* V, const bf16* G, bf16* mix, int colofs, const float* tbl,
                                          LAS float* sc, LAS float* qs, const LAS unsigned* keys, unsigned Tv, int Ti, int lane) {
    const int b = token / S, pos = token % S, c = pos >> 6;
    int k0, k1; size_t kbase;
    if (MODE == 0) { k0 = (c >= 8 ? c - 8 : 0) * 64; k1 = (c + 1) * 64; kbase = (size_t)b * S; }
    else if (MODE == 1) { k0 = 0; k1 = (c + 1) * 64; kbase = (size_t)b * S; }
    else { k0 = 0; k1 = NMEM; kbase = (size_t)b * NMEM; }
    qs[lane] = bf2f(Q[(size_t)token * GW + h * 64 + lane]);
    asm volatile("s_waitcnt lgkmcnt(0)" ::: "memory");
    float mx = -INFINITY;
    for (int key = k0 + lane; key < k1; key += 64) {
        const bf16* kr = K + (kbase + key) * GW + h * 64;
        float s = 0.f;
#pragma unroll 8
        for (int d = 0; d < 64; ++d) s += qs[d] * bf2f(kr[d]);
        if (MODE != 2) { int dd = pos - key; dd = dd < -128 ? -128 : (dd > 128 ? 128 : dd); s += tbl[h * 257 + dd + 128]; }
        if (MODE == 1) { const unsigned kv = keys[key]; if (!(kv > Tv || (kv == Tv && key <= Ti))) s = -INFINITY; }
        sc[key - k0] = s; mx = fmaxf(mx, s);
    }
    mx = wave_max(mx);
    float sum = 0.f;
    for (int key = k0 + lane; key < k1; key += 64) { const float p = __expf(sc[key - k0] - mx); sc[key - k0] = p; sum += p; }
    sum = wave_sum(sum);
    asm volatile("s_waitcnt lgkmcnt(0)" ::: "memory");
    float o = 0.f;
    for (int key = k0; key < k1; ++key) { const float p = sc[key - k0]; if (p != 0.f) o += p * bf2f(V[(kbase + key) * GW + h * 64 + lane]); }
    o /= sum;
    mix[(size_t)token * D + colofs + h * 64 + lane] = f2bf(o * bf2f(G[(size_t)token * GW + h * 64 + lane]));
    asm volatile("s_waitcnt lgkmcnt(0)" ::: "memory");
}
__device__ __forceinline__ int block_sum_i(int v, volatile LAS int* red, int tid) {
#pragma unroll
    for (int o = 1; o < 64; o <<= 1) v += __shfl_xor(v, o);
    __syncthreads();
    if ((tid & 63) == 0) red[tid >> 6] = v;
    __syncthreads();
    int s = 0;
#pragma unroll
    for (int w = 0; w < NWAVES; ++w) s += red[w];
    return s;
}
__device__ __forceinline__ void mixer_c_token(int token, const bf16* IQ, const bf16* IK, const float* IW, const bf16* Q, const bf16* K, const bf16* V, const bf16* G, bf16* mix, const float* tbl,
                                              LAS unsigned char* lds, int tid) {
    LAS unsigned* keys = (LAS unsigned*)(lds + RING_OFF);
    LAS float* qh = (LAS float*)(lds + SCR_OFF + 4096);
    LAS float* wq = (LAS float*)(lds + SCR_OFF + 4096 + 2048);
    volatile LAS int* red = (volatile LAS int*)(lds + SCR_OFF + 4096 + 2048 + 64);
    const int wave = tid >> 6, lane = tid & 63;
    const int b = token / S, pos = token % S, c = pos >> 6, n = (c + 1) * 64;
    qh[tid] = bf2f(IQ[(size_t)token * 512 + tid]);
    if (tid < 8) wq[tid] = IW[(size_t)token * 8 + tid] * 0.35355339059327373f;
    __syncthreads();
    for (int key = tid; key < n; key += 512) {
        const bf16* kr = IK + ((size_t)b * S + key) * 64;
        float score = 0.f;
        for (int h = 0; h < 8; ++h) {
            float s = 0.f;
#pragma unroll 8
            for (int d = 0; d < 64; ++d) s += qh[h * 64 + d] * bf2f(kr[d]);
            s *= 0.125f;
            score += fmaxf(s, 0.f) * wq[h];
        }
        const unsigned u = __float_as_uint(score);
        keys[key] = (u & 0x80000000u) ? ~u : (u | 0x80000000u);
    }
    __syncthreads();
    unsigned Tv = 0u; int Ti = 4095;
    if (n > 256) {
        unsigned prefix = 0u;
        for (int bit = 31; bit >= 0; --bit) {
            const unsigned cand = prefix | (1u << bit);
            int cnt = 0;
            for (int key = tid; key < n; key += 512) cnt += (keys[key] >= cand) ? 1 : 0;
            cnt = block_sum_i(cnt, red, tid);
            if (cnt >= 256) prefix = cand;
        }
        Tv = prefix;
        int cgt = 0;
        for (int key = tid; key < n; key += 512) cgt += (keys[key] > Tv) ? 1 : 0;
        cgt = block_sum_i(cgt, red, tid);
        const int r = 256 - cgt;
        int I = 0;
        for (int bit = 11; bit >= 0; --bit) {
            const int cand = I | (1 << bit);
            int cnt = 0;
            for (int key = tid; key < n; key += 512) cnt += (keys[key] == Tv && key < cand) ? 1 : 0;
            cnt = block_sum_i(cnt, red, tid);
            if (cnt < r) I = cand;
        }
        Ti = I;
    }
    if (wave < 4) attn_wave<1>(token, wave, Q, K, V, G, mix, 512, tbl, (LAS float*)(lds + RING_OFF + 16384 + wave * 16384), (LAS float*)(lds + SCR_OFF + wave * 256), keys, Tv, Ti, lane);
    __syncthreads();
}

template <int OFF> __device__ __forceinline__ unsigned long long karg_u64() {
    const __attribute__((address_space(4))) char* k = (const __attribute__((address_space(4))) char*)__builtin_amdgcn_kernarg_segment_ptr();
    unsigned long long v;
    asm volatile("s_load_dwordx2 %0, %1, %2\n\ts_waitcnt lgkmcnt(0)" : "=s"(v) : "s"(k), "i"(OFF) : "memory");
    return v;
}
#define IN_PTR(i) ((const float*)karg_u64<8 * (i)>())
#define OUT_PTR() ((float*)karg_u64<8 * 17>())
#define WS_PTR() ((unsigned char*)karg_u64<8 * 18>())
#define GRP(g) ((bf16*)(WS_PTR() + WS_P13) + (size_t)(g) * T * GW)
#define GRID_BAR() do { XcdBarrier b_; b_.bar = (unsigned*)((gu32*)(WS_PTR() + WS_CTL) + CW_BAR); b_.x = xb_xcc_id(); b_.st = (volatile LAS unsigned*)((LAS unsigned char*)lds_raw + MISC_OFF) + 8; xcd_barrier(b_); } while (0)

__global__ void __launch_bounds__(NWAVES * 64, 2) mk_fwd(Args args) {
    extern __shared__ __attribute__((aligned(16))) unsigned char lds_raw[];
    {
        LAS unsigned char* lds = (LAS unsigned char*)lds_raw;
        for (int u = threadIdx.x; u < (LDS_BYTES - LDSCTL_OFF) / 4; u += NWAVES * 64) ((LAS unsigned*)(lds + LDSCTL_OFF))[u] = 0u;
        __syncthreads();
        (void)xcd_barrier_post((unsigned*)((gu32*)(WS_PTR() + WS_CTL) + CW_BAR), (volatile LAS unsigned*)(lds + MISC_OFF) + 8);
    }
    {
        LAS unsigned char* lds = (LAS unsigned char*)lds_raw;
        const int tid = threadIdx.x, lane = tid & 63, wave = __builtin_amdgcn_readfirstlane(tid >> 6);
        const int G = gridDim.x, bx = blockIdx.x, vcu = (G % 8 == 0) ? (bx % 8) * (G / 8) + bx / 8 : bx;
        const int gw = vcu * NWAVES + wave, NGW = G * NWAVES;
        unsigned char* ws = WS_PTR();
        const float* w_in = IN_PTR(4); const float* w_out = IN_PTR(13);
        bf16* WIN = (bf16*)(ws + WS_WIN); bf16* WOUT = (bf16*)(ws + WS_WOUT);
        float* tbl = (float*)(ws + WS_TBL); float* bperm = (float*)(ws + WS_TBL + 65536);
        LAS float* scr = (LAS float*)(lds + RING_OFF + wave * 16384);
        constexpr int I_IN = 16 * 123, I_OUT = 16 * 32;
        for (int it = gw; it < 2 * I_IN + 2 * I_OUT; it += NGW) {
            int r = it;
            if (r < 2 * I_IN) { const int l = r / I_IN; transpose_item(w_in + (size_t)l * D * DIN, DIN, WIN + (size_t)l * DINP * D, true, scr, r % I_IN, lane); }
            else { r -= 2 * I_IN; const int l = r / I_OUT; transpose_item(w_out + (size_t)l * D * D, D, WOUT + (size_t)l * D * D, false, scr, r % I_OUT, lane); }
        }
        { const float* b_in = IN_PTR(5);
          for (int i = bx * 512 + tid; i < 2 * DINP; i += G * 512) { const int l = i / DINP, p = i % DINP; int col = -1;
              if (p < 3328) col = p; else if (p < 3584) col = 3400 + (p - 3328); else if (p < 3840) col = 3656 + (p - 3584); else if (p < 3904) col = 3328 + (p - 3840); else if (p < 3912) col = 3392 + (p - 3904);
              bperm[i] = col >= 0 ? b_in[l * DIN + col] : 0.f; } }
        { const float* t5 = IN_PTR(11);
          for (int i = bx * 512 + tid; i < 4 * 257; i += G * 512) {
            const int h = i / 257, d = i % 257 - 128, rel = -d, n = rel < 0 ? -rel : rel;
            int bucket = rel > 0 ? 16 : 0;
            if (n < 8) bucket += n; else { int large = 8 + (31 - __clz(n * n)) - 6; if (large > 15) large = 15; bucket += large; }
            tbl[i] = t5[bucket * 4 + h];
          } }
        { const float* x = IN_PTR(0); float* out = OUT_PTR(); bf16* HB = (bf16*)(ws + WS_HB); const float* g = IN_PTR(2); const float* b = IN_PTR(3);
          for (int m = gw; m < T; m += NGW) ln_row(x + (size_t)m * D, out + (size_t)m * D, HB + (size_t)m * D, g, b, lane); }
        __syncthreads();
        {
            const float* mem = IN_PTR(1); const float* w_mem = IN_PTR(12);
            LAS float* As = (LAS float*)(lds + RING_OFF); LAS float* Bs = As + 16 * 129;
            for (int it = bx; it < 256; it += G) { const int l = it >> 7, tt = it & 127;
                memkv_tile(mem, w_mem + (size_t)l * D * 512, (bf16*)(ws + WS_KM) + (size_t)l * NB * NMEM * 256, (bf16*)(ws + WS_VM) + (size_t)l * NB * NMEM * 256, tt >> 3, tt & 7, As, Bs, tid); }
        }
    }
    GRID_BAR();

    for (int l = 0; l < 2; ++l) {
#ifndef NO_P1
        {
            unsigned char* ws = WS_PTR();
            pg8::Gemm g{(const bf16*)(ws + WS_HB), (const bf16*)(ws + WS_WIN) + (size_t)l * DINP * D, T, DINP, D}; pg8::StaticOrder SO; SO.init(T, DINP, gridDim.x, blockIdx.x);
            pg8::EpiRoute E{(bf16*)(ws + WS_P13), (bf16*)(ws + WS_IQ), (bf16*)(ws + WS_IK), (float*)(ws + WS_IW), (const float*)(ws + WS_TBL + 65536) + l * DINP};
            pg8::gemm_phase<pg8::EpiRoute, pg8::StaticOrder, true, true>((LAS unsigned char*)lds_raw + RING_OFF, g, SO, E);
        }
#endif
        GRID_BAR();
#ifndef NO_P2
        {
            LAS unsigned char* lds = (LAS unsigned char*)lds_raw;
            int tid_ = threadIdx.x, G_ = gridDim.x, bx_ = blockIdx.x; asm volatile("" : "+v"(tid_), "+s"(G_), "+s"(bx_));
            const int tid = tid_, lane = tid & 63, wave = __builtin_amdgcn_readfirstlane(tid >> 6);
            const int G = G_, bx = bx_, vcu = (G % 8 == 0) ? (bx % 8) * (G / 8) + bx / 8 : bx;
            const int gw = vcu * NWAVES + wave, NGW = G * NWAVES;
            unsigned char* ws = WS_PTR();
            bf16* MIX = (bf16*)(ws + WS_MIX);
            const bf16* KM = (const bf16*)(ws + WS_KM) + (size_t)l * NB * NMEM * 256; const bf16* VM = (const bf16*)(ws + WS_VM) + (size_t)l * NB * NMEM * 256;
            for (int blk = bx; blk < T / 128; blk += G)
                mixer_a_unit(blk, GRP(G_AU), GRP(G_AV), GRP(G_AG), IN_PTR(6) + l * GW, IN_PTR(7) + l * GW, IN_PTR(8) + (size_t)l * 4 * 128 * 128, IN_PTR(9) + l * 4 * 128, MIX, (LAS float*)(lds + RING_OFF), tid);
            __syncthreads();
            {
                att::fill_bias(lds, IN_PTR(10) + (size_t)l * 4 * 257, tid);
                att::Cfg cfg{GRP(G_BQ), GRP(G_BK), GRP(G_BV), GRP(G_BG), MIX, 256};
                for (int u = vcu; u < NB * 64; u += G) { const int b = u >> 6, c = u & 63, kt0 = c >= 8 ? c - 8 : 0;
                    att::unit<0>(lds, cfg, b * S + c * 64, (size_t)b * S + kt0 * 64, c - kt0 + 1, (c - kt0) * 64, tid); }
            }
            {
                att::Cfg cfg{GRP(G_MQ), KM, VM, GRP(G_MG), MIX, 768};
                for (int u = vcu; u < NB * 64; u += G) { const int b = u >> 6, c = u & 63;
                    att::unit<2>(lds, cfg, b * S + c * 64, (size_t)b * NMEM, NMEM / 64, 0, tid); }
            }
            __syncthreads();
            for (int token = bx; token < T; token += G) mixer_c_token(token, (const bf16*)(ws + WS_IQ), (const bf16*)(ws + WS_IK), (const float*)(ws + WS_IW), GRP(G_CQ), GRP(G_CK), GRP(G_CV), GRP(G_CG), MIX, (const float*)(ws + WS_TBL), lds, tid);
        }
#endif
        GRID_BAR();
#ifndef NO_P3
        {
            unsigned char* ws = WS_PTR();
            pg8::Gemm g{(const bf16*)(ws + WS_MIX), (const bf16*)(ws + WS_WOUT) + (size_t)l * D * D, T, D, D}; pg8::StaticOrder SO; SO.init(T, D, gridDim.x, blockIdx.x);
            pg8::EpiResid E{OUT_PTR(), IN_PTR(14) + l * D};
            pg8::gemm_phase<pg8::EpiResid, pg8::StaticOrder, true, true>((LAS unsigned char*)lds_raw + RING_OFF, g, SO, E);
        }
#endif
        GRID_BAR();
        {
            int tid_ = threadIdx.x, G_ = gridDim.x, bx_ = blockIdx.x; asm volatile("" : "+v"(tid_), "+s"(G_), "+s"(bx_));
            const int tid = tid_, lane = tid & 63, wave = __builtin_amdgcn_readfirstlane(tid >> 6);
            const int G = G_, bx = bx_, vcu = (G % 8 == 0) ? (bx % 8) * (G / 8) + bx / 8 : bx;
            const int gw = vcu * NWAVES + wave, NGW = G * NWAVES;
            float* out = OUT_PTR(); bf16* HB = (bf16*)(WS_PTR() + WS_HB); const float* g = IN_PTR(15) + l * D; const float* b = IN_PTR(16) + l * D;
            for (int m = gw; m < T; m += NGW) ln_row(out + (size_t)m * D, out + (size_t)m * D, HB + (size_t)m * D, g, b, lane);
        }
        if (l == 0) GRID_BAR();
    }
}

extern "C" void kernel_launch(void* const* d_in, const int* in_sizes, int n_in, void* d_out, int out_size, void* d_ws, size_t ws_size, hipStream_t stream) {
    static int grid = 0;
    if (grid == 0) {
        if (n_in != 17 || out_size != T * D || ws_size < WS_END) { fprintf(stderr, "kernel_launch: unexpected n_in %d / out_size %d / ws_size %zu; nothing launched\n", n_in, out_size, ws_size); grid = -1; return; }
        int dev = 0, cus = 0, per_cu = 0;
        if (hipGetDevice(&dev) != hipSuccess || hipDeviceGetAttribute(&cus, hipDeviceAttributeMultiprocessorCount, dev) != hipSuccess) { grid = -1; return; }
        if (hipFuncSetAttribute((const void*)mk_fwd, hipFuncAttributeMaxDynamicSharedMemorySize, LDS_BYTES) != hipSuccess) { fprintf(stderr, "kernel_launch: hipFuncSetAttribute failed\n"); grid = -1; return; }
        if (hipOccupancyMaxActiveBlocksPerMultiprocessor(&per_cu, (const void*)mk_fwd, NWAVES * 64, LDS_BYTES) != hipSuccess || per_cu < 1) { fprintf(stderr, "kernel_launch: occupancy query says %d blocks per CU; nothing launched\n", per_cu); (void)hipGetLastError(); grid = -1; return; }
        grid = cus;
    }
    if (grid < 0) return;
    if (hipMemsetAsync((char*)d_ws + WS_CTL, 0, CTL_ZERO_BYTES, stream) != hipSuccess) { fprintf(stderr, "kernel_launch: memset failed\n"); return; }
    Args a{};
    for (int i = 0; i < 17; ++i) a.in[i] = (const float*)d_in[i];
    a.out = (float*)d_out; a.ws = (unsigned char*)d_ws;
    hipLaunchKernelGGL(mk_fwd, dim3(grid), dim3(NWAVES * 64), LDS_BYTES, stream, a);
}
```

```cpp
#include <hip/hip_runtime.h>
#include <cstdio>
#include <cstdint>
namespace pg8 {
#define PG8_LAS __attribute__((address_space(3)))
typedef unsigned short bf16_t;
typedef short bf16x8 __attribute__((ext_vector_type(8)));
typedef float f32x4 __attribute__((ext_vector_type(4)));
typedef unsigned u32x4 __attribute__((ext_vector_type(4)));
constexpr int BM = 256, BK = 64, HALF = 128, HTB = HALF * BK * 2  , STAGE_BYTES = 8 * HTB, NXCD = 8, WGM = 8;

__host__ __device__ __forceinline__ int lds_byte(int r, int c) { const int st = (r >> 4) * 2 + (c >> 5), rr = r & 15, cc = c & 31, ob = rr * 64 + cc * 2; return st * 1024 + (ob ^ (((ob >> 9) & 1) << 5)); }
__host__ __device__ __forceinline__ void stage_rc(int b, int& R, int& C) { const int st = b / 1024, sb = b % 1024, swz = sb ^ (((sb >> 9) & 1) << 5); R = (st >> 1) * 16 + swz / 64; C = (st & 1) * 32 + (swz % 64) / 2; }
__host__ __device__ __forceinline__ int perm32(int rho) { const int n = rho >> 4, i = rho & 15; return 8 * (i >> 2) + 4 * n + (i & 3); }

struct Unit { int pm, pn; };
struct Gemm { const bf16_t* A; const bf16_t* Bt; int M, N, K; };

struct StaticOrder {
    int nM, nN, nwg, G, c;
    __host__ __device__ void init(int M, int N, int G_, int c_) { nM = M / BM; nN = N / BM; nwg = nM * nN; G = G_; c = c_; }
    __host__ __device__ bool next(int i, Unit& u) const {
        const long L = (long)i * G + c; if (L >= nwg) return false;
        int wgid = (int)L; { const int q = nwg / NXCD, r = nwg % NXCD, xcd = wgid % NXCD, off = wgid / NXCD; wgid = (xcd < r ? xcd * (q + 1) : r * (q + 1) + (xcd - r) * q) + off; }
        const int nig = WGM * nN, gid = wgid / nig, fm = gid * WGM, gsz = (nM - fm) < WGM ? (nM - fm) : WGM;
        u.pm = fm + ((wgid % nig) % gsz); u.pn = (wgid % nig) / gsz; return true;
    }
    __device__ __forceinline__ void a_ready(const Unit&) const {}
    __device__ __forceinline__ void done(const Unit&) const {}
};

__device__ __forceinline__ unsigned cvt_pk_bf16(float lo, float hi) { unsigned r; asm volatile("v_cvt_pk_bf16_f32 %0, %1, %2" : "=v"(r) : "v"(lo), "v"(hi)); return r; }
typedef float f32x2 __attribute__((ext_vector_type(2)));
template <class Epi, class Sched, bool ALIGN_EPI = false, bool SP2 = false>
__device__ __forceinline__ void gemm_phase(PG8_LAS unsigned char* lds, const Gemm g, const Sched& S, const Epi& E) {
    const int tid = threadIdx.x, wid = __builtin_amdgcn_readfirstlane(tid >> 6), lane = tid & 63, wr = wid >> 2, wc = wid & 3, fr = lane & 15, fq = lane >> 4;
    const int K = g.K, nt = K / BK;
    unsigned voffA[2], voffB[2];
#pragma unroll
    for (int i = 0; i < 2; ++i) { int R, C; stage_rc(tid * 16 + i * 8192, R, C); const int Rb = Epi::PERM ? ((R & ~31) + perm32(R & 31)) : R;
        voffA[i] = (unsigned)(R * K + C) * 2u; voffB[i] = (unsigned)(Rb * K + C) * 2u; }
    const size_t kstep = (size_t)(BK * 2);
    const size_t hstep = (size_t)HALF * K * 2;
    const size_t tstep = 2 * hstep;
    const unsigned ldsw = (unsigned)wid * 1024u;
    const int aoff = lds_byte(wr * 64 + fr, fq * 8), boff = lds_byte(wc * 32 + fr, fq * 8);
#define PG8_SA(b, h) (((b) * 2 + (h)) * HTB)
#define PG8_SB(b, h) ((4 + (b) * 2 + (h)) * HTB)
#define PG8_STAGE(bufoff, gbase, voff) do { _Pragma("unroll") for (int _i = 0; _i < 2; ++_i) \
        __builtin_amdgcn_global_load_lds((const unsigned*)((const char*)(gbase) + (voff)[_i]), (PG8_LAS unsigned*)(lds + (bufoff) + ldsw + _i * 8192), 16, 0, 0); } while (0)
#define PG8_LDA(dst, b, h) do { _Pragma("unroll") for (int m = 0; m < 4; ++m) _Pragma("unroll") for (int k = 0; k < 2; ++k) dst[m][k] = *(const PG8_LAS bf16x8*)(lds + PG8_SA(b, h) + aoff + m * 2048 + k * 1024); } while (0)
#define PG8_LDB(dst, b, h) do { _Pragma("unroll") for (int n = 0; n < 2; ++n) _Pragma("unroll") for (int k = 0; k < 2; ++k) dst[n][k] = *(const PG8_LAS bf16x8*)(lds + PG8_SB(b, h) + boff + n * 2048 + k * 1024); } while (0)
#define PG8_MMA(ai, bj, At, Bt) do { __builtin_amdgcn_s_setprio(1); _Pragma("unroll") for (int m = 0; m < 4; ++m) _Pragma("unroll") for (int n = 0; n < 2; ++n) _Pragma("unroll") for (int k = 0; k < 2; ++k) \
        acc[ai][bj][m][n] = __builtin_amdgcn_mfma_f32_16x16x32_bf16(Bt[n][k], At[m][k], acc[ai][bj][m][n], 0, 0, 0); __builtin_amdgcn_s_setprio(0); } while (0)
#define PG8_WAIT_V(n) asm volatile("s_waitcnt vmcnt(" #n ")" ::: "memory")
#define PG8_WAIT_L(n) asm volatile("s_waitcnt lgkmcnt(" #n ")" ::: "memory")
#define PG8_BAR __builtin_amdgcn_s_barrier()
#define PG8_SCHED __builtin_amdgcn_sched_barrier(0)
    Unit cur, nxt; int ui = 0;
    if (!S.next(0, cur)) return;
    f32x4 acc[2][2][4][2];
#pragma unroll
    for (int a = 0; a < 2; ++a)
#pragma unroll
        for (int b = 0; b < 2; ++b)
#pragma unroll
            for (int m = 0; m < 4; ++m)
#pragma unroll
                for (int n = 0; n < 2; ++n) acc[a][b][m][n] = (f32x4){0.f, 0.f, 0.f, 0.f};
    bf16x8 At[4][2], B0[2][2], B1[2][2];
    const char* cA = (const char*)g.A + (size_t)cur.pm * tstep; const char* cB = (const char*)g.Bt + (size_t)cur.pn * tstep;
    S.a_ready(cur);
    if constexpr (SP2) {
        PG8_STAGE(PG8_SB(0, 0), cB, voffB); PG8_STAGE(PG8_SB(0, 1), cB + hstep, voffB); PG8_STAGE(PG8_SA(0, 0), cA, voffA); PG8_STAGE(PG8_SA(0, 1), cA + hstep, voffA);
        if (wr == 1) PG8_BAR;
        PG8_WAIT_V(2); PG8_BAR;
        PG8_STAGE(PG8_SB(1, 0), cB + kstep, voffB); PG8_STAGE(PG8_SA(1, 0), cA + kstep, voffA); PG8_STAGE(PG8_SB(1, 1), cB + hstep + kstep, voffB);
        PG8_WAIT_V(6); PG8_BAR;
    } else {
        PG8_STAGE(PG8_SB(0, 0), cB, voffB); PG8_STAGE(PG8_SA(0, 0), cA, voffA); PG8_STAGE(PG8_SB(0, 1), cB + hstep, voffB); PG8_STAGE(PG8_SA(0, 1), cA + hstep, voffA);
        if (wr == 1) PG8_BAR;
        PG8_WAIT_V(4); PG8_BAR;
        PG8_STAGE(PG8_SB(1, 0), cB + kstep, voffB); PG8_STAGE(PG8_SA(1, 0), cA + kstep, voffA); PG8_STAGE(PG8_SB(1, 1), cB + hstep + kstep, voffB);
        PG8_WAIT_V(6); PG8_BAR;
    }
    for (;;) {
        const bool has_next = S.next(ui + 1, nxt);
        const char* nA = has_next ? (const char*)g.A + (size_t)nxt.pm * tstep : cA; const char* nB = has_next ? (const char*)g.Bt + (size_t)nxt.pn * tstep : cB;
        for (int t = 0; t < nt; t += 2) {
            const bool last = (t == nt - 2);
            const char* a1 = cA + (size_t)(t + 1) * kstep;
            const char* a2 = last ? nA : cA + (size_t)(t + 2) * kstep; const char* b2 = last ? nB : cB + (size_t)(t + 2) * kstep;
            const char* a3 = a2 + kstep; const char* b3 = b2 + kstep;
            if (last && has_next) S.a_ready(nxt);
            if constexpr (SP2) {
            PG8_LDB(B0, 0, 0); PG8_LDB(B1, 0, 1); PG8_SCHED; PG8_LDA(At, 0, 0); PG8_STAGE(PG8_SA(1, 1), a1 + hstep, voffA);
            PG8_WAIT_V(8); PG8_WAIT_L(0); PG8_BAR; PG8_MMA(0, 0, At, B0); PG8_MMA(0, 1, At, B1); PG8_BAR; PG8_SCHED;
            PG8_LDA(At, 0, 1); PG8_STAGE(PG8_SB(0, 0), b2, voffB); PG8_STAGE(PG8_SB(0, 1), b2 + hstep, voffB); PG8_STAGE(PG8_SA(0, 0), a2, voffA);
            PG8_WAIT_V(8); PG8_WAIT_L(0); PG8_BAR; PG8_MMA(1, 0, At, B0); PG8_MMA(1, 1, At, B1); PG8_BAR; PG8_SCHED;
            PG8_LDB(B0, 1, 0); PG8_LDB(B1, 1, 1); PG8_SCHED; PG8_LDA(At, 1, 0); PG8_STAGE(PG8_SA(0, 1), a2 + hstep, voffA);
            PG8_WAIT_V(8); PG8_WAIT_L(0); PG8_BAR; PG8_MMA(0, 0, At, B0); PG8_MMA(0, 1, At, B1); PG8_BAR; PG8_SCHED;
            PG8_LDA(At, 1, 1); PG8_STAGE(PG8_SB(1, 0), b3, voffB); PG8_STAGE(PG8_SB(1, 1), b3 + hstep, voffB); PG8_STAGE(PG8_SA(1, 0), a3, voffA);
            PG8_WAIT_V(8); PG8_WAIT_L(0); PG8_BAR; PG8_MMA(1, 0, At, B0); PG8_MMA(1, 1, At, B1); PG8_BAR; PG8_SCHED;
            } else {
            PG8_LDB(B0, 0, 0); PG8_SCHED; PG8_LDA(At, 0, 0); PG8_STAGE(PG8_SA(1, 1), a1 + hstep, voffA);
            PG8_WAIT_L(8); PG8_BAR; PG8_WAIT_L(0); PG8_MMA(0, 0, At, B0); PG8_BAR; PG8_SCHED;
            PG8_LDB(B1, 0, 1); PG8_STAGE(PG8_SB(0, 0), b2, voffB);
            PG8_BAR; PG8_WAIT_L(0); PG8_MMA(0, 1, At, B1); PG8_BAR;
            PG8_LDA(At, 0, 1); PG8_STAGE(PG8_SA(0, 0), a2, voffA);
            PG8_BAR; PG8_WAIT_L(0); PG8_MMA(1, 0, At, B0); PG8_BAR; PG8_SCHED;
            PG8_STAGE(PG8_SB(0, 1), b2 + hstep, voffB);
            PG8_WAIT_V(6); PG8_BAR; PG8_MMA(1, 1, At, B1); PG8_BAR;
            PG8_LDB(B0, 1, 0); PG8_SCHED; PG8_LDA(At, 1, 0); PG8_STAGE(PG8_SA(0, 1), a2 + hstep, voffA);
            PG8_WAIT_L(8); PG8_BAR; PG8_WAIT_L(0); PG8_MMA(0, 0, At, B0); PG8_BAR; PG8_SCHED;
            PG8_LDB(B1, 1, 1); PG8_STAGE(PG8_SB(1, 0), b3, voffB);
            PG8_BAR; PG8_WAIT_L(0); PG8_MMA(0, 1, At, B1); PG8_BAR;
            PG8_LDA(At, 1, 1); PG8_STAGE(PG8_SA(1, 0), a3, voffA);
            PG8_BAR; PG8_WAIT_L(0); PG8_MMA(1, 0, At, B0); PG8_BAR; PG8_SCHED;
            PG8_STAGE(PG8_SB(1, 1), b3 + hstep, voffB);
            PG8_WAIT_V(6); PG8_BAR; PG8_MMA(1, 1, At, B1); PG8_BAR;
            }
        }
        if constexpr (ALIGN_EPI) { if (wr == 0) PG8_BAR; }
        if constexpr (!Epi::AFTER_DRAIN) { E(acc, cur, wr, wc, fr, fq); S.done(cur); }
        if (!has_next) break;
#pragma unroll
        for (int a = 0; a < 2; ++a)
#pragma unroll
            for (int b = 0; b < 2; ++b)
#pragma unroll
                for (int m = 0; m < 4; ++m)
#pragma unroll
                    for (int n = 0; n < 2; ++n) acc[a][b][m][n] = (f32x4){0.f, 0.f, 0.f, 0.f};
        cur = nxt; cA = nA; cB = nB; ++ui;
        if constexpr (ALIGN_EPI) { if (wr == 1) PG8_BAR; }
    }
    PG8_WAIT_V(0);
    if constexpr (!ALIGN_EPI) { if (wr == 0) PG8_BAR; }
    PG8_BAR;
    if constexpr (Epi::AFTER_DRAIN) { E.fused(acc, cur, wr, wc, fr, fq, lds, wid, lane); S.done(cur); }
#undef PG8_SA
#undef PG8_SB
#undef PG8_STAGE
#undef PG8_LDA
#undef PG8_LDB
#undef PG8_MMA
#undef PG8_WAIT_V
#undef PG8_WAIT_L
#undef PG8_BAR
#undef PG8_SCHED
}
}
typedef unsigned short bf16;
constexpr int NB = 8, S = 4096, D = 1024, T = NB * S, GW = 256, DIN = 3912, DINP = 4096, NMEM = 256;
constexpr float LN_EPS = 1e-5f;
constexpr float ALPHA = 1.41421356237309515f;
constexpr size_t MiB = 1u << 20;
constexpr size_t WS_CTL = 0, CTL_ZERO_BYTES = 1 * MiB;
constexpr size_t WS_WIN = 2 * MiB;
constexpr size_t WS_WOUT = 18 * MiB;
constexpr size_t WS_TBL = 22 * MiB;
constexpr size_t WS_KM = 24 * MiB;
constexpr size_t WS_VM = 26 * MiB;
constexpr size_t WS_HB = 32 * MiB;
constexpr size_t WS_MIX = 96 * MiB;
constexpr size_t WS_P13 = 160 * MiB;
constexpr size_t WS_IQ = 368 * MiB;
constexpr size_t WS_IK = 400 * MiB;
constexpr size_t WS_IW = 404 * MiB;
constexpr size_t WS_END = 406 * MiB;
enum Grp { G_AU = 0, G_AV, G_AG, G_BQ, G_BK, G_BV, G_BG, G_CQ, G_CK, G_CV, G_CG, G_MQ, G_MG };
constexpr int CW_BAR = 4096;

__device__ __forceinline__ float bf2f(bf16 v) { return __uint_as_float((unsigned)v << 16); }
__device__ __forceinline__ bf16 f2bf(float f) { unsigned u = __float_as_uint(f); return (bf16)((u + 0x7fffu + ((u >> 16) & 1u)) >> 16); }
__device__ __forceinline__ float fast_sigmoid(float x) { return __builtin_amdgcn_rcpf(1.f + __builtin_amdgcn_exp2f(-1.4426950408889634f * x)); }
__device__ __forceinline__ float gelu_tanh(float x) { const float u = 0.7978845608028654f * (x + 0.044715f * x * x * x); return x * fast_sigmoid(2.f * u); }
__device__ __forceinline__ float silu(float x) { return x * fast_sigmoid(x); }
__device__ __forceinline__ float wave_sum(float v) {
#pragma unroll
    for (int o = 1; o < 64; o <<= 1) v += __shfl_xor(v, o);
    return v;
}
__device__ __forceinline__ float wave_max(float v) {
#pragma unroll
    for (int o = 1; o < 64; o <<= 1) v = fmaxf(v, __shfl_xor(v, o));
    return v;
}
__host__ __device__ __forceinline__ int perm_col(int col) {
    if (col < 3328) return col;
    if (col < 3392) return 3840 + (col - 3328);
    if (col < 3400) return 3904 + (col - 3392);
    if (col < 3656) return 3328 + (col - 3400);
    return 3584 + (col - 3656);
}

namespace pg8 {
__device__ __forceinline__ f32x4 act4(f32x4 v, int mode) {
    if (mode == 1) { v[0] = gelu_tanh(v[0]); v[1] = gelu_tanh(v[1]); v[2] = gelu_tanh(v[2]); v[3] = gelu_tanh(v[3]); }
    else if (mode == 2) { v[0] = silu(v[0]); v[1] = silu(v[1]); v[2] = silu(v[2]); v[3] = silu(v[3]); }
    else if (mode == 3) { v = v * 0.125f; }
    else if (mode == 4) { v = v * (0.125f * 1.4426950408889634f); }
    return v;
}
struct EpiRoute {
    static constexpr bool PERM = true, AFTER_DRAIN = false;
    bf16_t* p13; bf16_t* iq; bf16_t* ik; float* iw; const float* bias;
    __device__ __forceinline__ void operator()(const f32x4 (&acc)[2][2][4][2], const Unit& u, int wr, int wc, int fr, int fq) const {
        const int pn = u.pn, row0 = u.pm * BM + wr * 64 + fr, cl0 = wc * 32 + 8 * fq;
        f32x4 bv[2][2];
#pragma unroll
        for (int bj = 0; bj < 2; ++bj)
#pragma unroll
            for (int n = 0; n < 2; ++n) bv[bj][n] = *(const f32x4*)(bias + pn * BM + bj * HALF + cl0 + 4 * n);
        if (pn == 15) {
#pragma unroll
            for (int ai = 0; ai < 2; ++ai)
#pragma unroll
                for (int m = 0; m < 4; ++m) { const size_t row = (size_t)(row0 + ai * HALF + m * 16);
                    const f32x4 v0 = acc[ai][0][m][0] + bv[0][0], v1 = acc[ai][0][m][1] + bv[0][1];
                    if (wc < 2) { u32x4 w; w.x = cvt_pk_bf16(v0[0], v0[1]); w.y = cvt_pk_bf16(v0[2], v0[3]); w.z = cvt_pk_bf16(v1[0], v1[1]); w.w = cvt_pk_bf16(v1[2], v1[3]); *(u32x4*)(ik + row * 64 + cl0) = w; }
                    else if (wc == 2 && fq == 0) { *(f32x4*)(iw + row * 8) = v0; *(f32x4*)(iw + row * 8 + 4) = v1; } }
            return;
        }
        bf16_t* base; int ldc, mode;
        if (pn <= 10) { base = p13 + (size_t)pn * T * GW; ldc = GW; mode = (pn == G_AU || pn == G_AV) ? 1 : (pn == G_AG || pn == G_BG || pn == G_CG) ? 2 : (pn == G_BQ || pn == G_CQ) ? 4 : 0; }
        else if (pn <= 12) { base = iq + (pn - 11) * 256; ldc = 512; mode = 0; }
        else if (pn == 13) { base = p13 + (size_t)G_MQ * T * GW; ldc = GW; mode = 4; }
        else { base = p13 + (size_t)G_MG * T * GW; ldc = GW; mode = 2; }
#pragma unroll
        for (int ai = 0; ai < 2; ++ai)
#pragma unroll
            for (int m = 0; m < 4; ++m) { bf16_t* rowp = base + (size_t)(row0 + ai * HALF + m * 16) * ldc + cl0;
#pragma unroll
                for (int bj = 0; bj < 2; ++bj) { const f32x4 v0 = act4(acc[ai][bj][m][0] + bv[bj][0], mode), v1 = act4(acc[ai][bj][m][1] + bv[bj][1], mode);
                    u32x4 w; w.x = cvt_pk_bf16(v0[0], v0[1]); w.y = cvt_pk_bf16(v0[2], v0[3]); w.z = cvt_pk_bf16(v1[0], v1[1]); w.w = cvt_pk_bf16(v1[2], v1[3]);
                    *(u32x4*)(rowp + bj * HALF) = w; } }
    }
};
struct EpiResid {
    static constexpr bool PERM = false, AFTER_DRAIN = false;
    float* out; const float* bias;
    __device__ __forceinline__ void operator()(const f32x4 (&acc)[2][2][4][2], const Unit& u, int wr, int wc, int fr, int fq) const {
        const int col0 = u.pn * BM + wc * 32 + 4 * fq;
#pragma unroll
        for (int ai = 0; ai < 2; ++ai)
#pragma unroll
            for (int m = 0; m < 4; ++m) { float* rowp = out + (size_t)(u.pm * BM + ai * HALF + wr * 64 + m * 16 + fr) * D + col0;
#pragma unroll
                for (int bj = 0; bj < 2; ++bj)
#pragma unroll
                    for (int n = 0; n < 2; ++n) { float* p = rowp + bj * HALF + n * 16; const f32x4 bv = *(const f32x4*)(bias + col0 + bj * HALF + n * 16);
                        const f32x4 h = *(const f32x4*)p; *(f32x4*)p = h * ALPHA + acc[ai][bj][m][n] + bv; } }
    }
};
}
#define GAS __attribute__((address_space(1)))
#define LAS __attribute__((address_space(3)))
typedef unsigned short bf16;
typedef unsigned v4u __attribute__((ext_vector_type(4)));
typedef float f32x4 __attribute__((ext_vector_type(4)));
typedef short bf16x8 __attribute__((ext_vector_type(8)));
typedef GAS unsigned gu32;
typedef GAS unsigned long long gu64;
#define RLX_AGENT __ATOMIC_RELAXED, __HIP_MEMORY_SCOPE_AGENT
#define LDS_WAIT() asm volatile("s_waitcnt lgkmcnt(0)" ::: "memory")
#define VM_WAIT() asm volatile("s_waitcnt vmcnt(0)" ::: "memory")
__device__ __forceinline__ unsigned long long rt() { return __builtin_amdgcn_s_memrealtime(); }
__device__ __forceinline__ unsigned pk2(float lo, float hi) { return (unsigned)f2bf(lo) | ((unsigned)f2bf(hi) << 16); }

#define XB_TMO      128
#define XB_XCNT(j)  (256  + 64 * (j))
#define XB_XSUB(j)  (1280 + 64 * (j))
#define XB_XGEN(j)  (2304 + 64 * (j))
#define XB_TOP      3328
#define XB_TOPGEN   3392
#define XCD_BAR_WORDS 3456
#define XB_SPIN_CAP (1u << 18)

__device__ __forceinline__ unsigned xb_ld(unsigned* p)              { return __hip_atomic_load(p, __ATOMIC_RELAXED, __HIP_MEMORY_SCOPE_AGENT); }
__device__ __forceinline__ unsigned xb_add(unsigned* p, unsigned v) { return __hip_atomic_fetch_add(p, v, __ATOMIC_RELAXED, __HIP_MEMORY_SCOPE_AGENT); }
__device__ __forceinline__ unsigned xb_xcc_id() { return (unsigned)__builtin_amdgcn_s_getreg((3 << 11) | 20) & 0xFu; }
#define XB_SPIN(cond, bar) do { unsigned _sp = 0; while (cond) { __builtin_amdgcn_s_sleep(1); \
    if ((++_sp & 255u) == 0u) { if (xb_ld(&(bar)[XB_TMO])) break; if (_sp > XB_SPIN_CAP) { atomicAdd(&(bar)[XB_TMO], 1u); break; } } } } while (0)

struct XcdBarrier {
    unsigned* bar; unsigned x;
    volatile LAS unsigned* st;
};

__device__ __forceinline__ XcdBarrier xcd_barrier_post(unsigned* bar, volatile LAS unsigned* st) {
    XcdBarrier b; b.bar = bar; b.x = xb_xcc_id(); b.st = st;
    if (threadIdx.x == 0) (void)xb_add(&bar[XB_XCNT(b.x)], 1u);
    return b;
}
__device__ __forceinline__ void xcd_barrier_complete(unsigned* bar, unsigned x, unsigned& nloc, unsigned& nx) {
    const unsigned G = gridDim.x * gridDim.y * gridDim.z;
    unsigned sum, cnt, mine, sp = 0u;
    for (;;) {
        sum = 0u; cnt = 0u; mine = 0u;
#pragma unroll
        for (unsigned j = 0; j < 16; ++j) { const unsigned c = xb_ld(&bar[XB_XCNT(j)]); sum += c; cnt += (c > 0u) ? 1u : 0u; mine = (j == x) ? c : mine; }
        if (sum == G) break;
        __builtin_amdgcn_s_sleep(1);
        if ((++sp & 255u) == 0u) { if (xb_ld(&bar[XB_TMO])) break; if (sp > XB_SPIN_CAP) { atomicAdd(&bar[XB_TMO], 1u); break; } }
    }
    nloc = mine > 0u ? mine : 1u; nx = cnt > 0u ? cnt : 1u;
}

__device__ __forceinline__ void xcd_barrier(const XcdBarrier& b) {
    asm volatile("s_waitcnt vmcnt(0)" ::: "memory");
    __syncthreads();
    if (threadIdx.x == 0) {
        unsigned* bar = b.bar;
        __builtin_amdgcn_s_waitcnt(0);
        unsigned nloc = b.st[0], nx = b.st[1];
        if (nloc == 0u) { xcd_barrier_complete(bar, b.x, nloc, nx); b.st[0] = nloc; b.st[1] = nx; }
        const unsigned old = xb_add(&bar[XB_XSUB(b.x)], 1u);
        const unsigned gen = old / nloc;
        if (old + 1u == (gen + 1u) * nloc) {
            __builtin_amdgcn_fence(__ATOMIC_RELEASE, "agent");
            asm volatile("s_waitcnt vmcnt(0)" ::: "memory");
            const unsigned og = xb_add(&bar[XB_TOP], 1u);
            const unsigned tg = og / nx;
            if (og + 1u == (tg + 1u) * nx) xb_add(&bar[XB_TOPGEN], 1u);
            else XB_SPIN(xb_ld(&bar[XB_TOPGEN]) == tg, bar);
            __builtin_amdgcn_fence(__ATOMIC_ACQUIRE, "agent");
            xb_add(&bar[XB_XGEN(b.x)], 1u);
            asm volatile("s_waitcnt vmcnt(0)" ::: "memory");
        } else {
            XB_SPIN(xb_ld(&bar[XB_XGEN(b.x)]) == gen, bar);
            __builtin_amdgcn_fence(__ATOMIC_ACQUIRE, "agent");
            asm volatile("s_waitcnt vmcnt(0)" ::: "memory");
        }
    }
    __syncthreads();
}
namespace att {
typedef short bf16x8 __attribute__((ext_vector_type(8)));
typedef short s16x4 __attribute__((ext_vector_type(4)));
typedef float f32x16 __attribute__((ext_vector_type(16)));
typedef float f32x2_t __attribute__((ext_vector_type(2)));
typedef __bf16 bf16x2_t __attribute__((ext_vector_type(2)));
typedef unsigned u32x4 __attribute__((ext_vector_type(4)));
typedef unsigned u32x2 __attribute__((ext_vector_type(2)));
constexpr int L_K = 0, L_V = 32768, L_OST = 65536, L_BM = 98304, BM_STRIDE = 130  , L_BIAS = L_BM + 64 * BM_STRIDE * 4  , L_WS = L_BIAS + 4352  , L_END = L_WS + 8 * 256;
constexpr float LOG2E = 1.4426950408889634f;
__device__ __forceinline__ int crow(int r, int hi) { return (r & 3) + 8 * (r >> 2) + 4 * hi; }
__device__ __forceinline__ unsigned cvtpk(float lo, float hi) { f32x2_t v = {lo, hi}; bf16x2_t b = __builtin_convertvector(v, bf16x2_t); return __builtin_bit_cast(unsigned, b); }
__device__ __forceinline__ s16x4 vtr(const LAS unsigned char* p) { typedef short v4i16_t __attribute__((ext_vector_type(4))); return __builtin_bit_cast(s16x4, __builtin_amdgcn_ds_read_tr16_b64_v4i16((LAS v4i16_t*)p)); }

__device__ __forceinline__ void fill_bias(LAS unsigned char* lds, const float* tbl, int tid) {
    LAS float* bl = (LAS float*)(lds + L_BIAS);
    for (int i = tid; i < 4 * 257; i += 512) { const int h = i / 257; bl[i] = (tbl[i] - tbl[h * 257 + 256]) * LOG2E; }
}

struct Cfg { const bf16* Q; const bf16* K; const bf16* V; const bf16* Gt; bf16* mix; int colofs; };

template <int MODE>
__device__ __forceinline__ void unit(LAS unsigned char* lds, const Cfg& A, int tok0, size_t kvrow0, int ntiles, int delta0, int tid_in) {
    int tid = tid_in; asm volatile("" : "+v"(tid));
    const int lane = tid & 63, wave = __builtin_amdgcn_readfirstlane(tid >> 6), h = wave >> 1, qh = wave & 1, r32 = lane & 31, hi = lane >> 5;
    const int qloc = 32 * qh + r32;
    bf16x8 qr[4];
    { const bf16* qp = A.Q + (size_t)(tok0 + qloc) * GW + h * 64 + 8 * hi;
#pragma unroll
      for (int d0 = 0; d0 < 4; ++d0) qr[d0] = *(const bf16x8*)(qp + 16 * d0); }
    const int k0 = tid >> 5, rem = tid & 31, sh = rem >> 3, ch = rem & 7;
    const unsigned kw = L_K + sh * 8192 + ch * 1024 + ((k0 ^ ch) << 4);
    const unsigned vw = L_V + sh * 8192 + (ch >> 2) * 4096 + (k0 >> 3) * 512 + (k0 & 7) * 64 + (ch & 3) * 16;
    const bf16* kg = A.K + (kvrow0 + k0) * GW + rem * 8;
    const bf16* vg = A.V + (kvrow0 + k0) * GW + rem * 8;
    u32x4 kreg[4], vreg[4];
#pragma unroll
    for (int i = 0; i < 4; ++i) { kreg[i] = *(const u32x4*)(kg + (size_t)(16 * i) * GW); vreg[i] = *(const u32x4*)(vg + (size_t)(16 * i) * GW); }
    const LAS unsigned char* kb = lds + L_K + h * 8192 + hi * 1024;
    const LAS unsigned char* vb = lds + L_V + h * 8192 + ((lane >> 4) & 1) * 32 + (lane & 3) * 8 + (4 * hi + ((lane & 15) >> 2)) * 64;
    LAS float* wsf = (LAS float*)(lds + L_WS + wave * 256);
    const LAS float* biasL = (const LAS float*)(lds + L_BIAS) + h * 257;
    const LAS unsigned* bmrow = (const LAS unsigned*)(lds + L_BM) + qloc * BM_STRIDE;
    f32x16 o0 = {}, o1 = {};
    float mrun = -INFINITY, lsum = 0.f;
    for (int t = 0; t < ntiles; ++t) {
        __syncthreads();
#pragma unroll
        for (int i = 0; i < 4; ++i) { *(LAS u32x4*)(lds + kw + 256 * i) = kreg[i]; *(LAS u32x4*)(lds + vw + 1024 * i) = vreg[i]; }
        __syncthreads();
        if (t + 1 < ntiles) {
#pragma unroll
            for (int i = 0; i < 4; ++i) { kreg[i] = *(const u32x4*)(kg + (size_t)((t + 1) * 64 + 16 * i) * GW); vreg[i] = *(const u32x4*)(vg + (size_t)((t + 1) * 64 + 16 * i) * GW); }
        }
        f32x16 p0 = {}, p1 = {};
#pragma unroll
        for (int d0 = 0; d0 < 4; ++d0) {
            const int chunk = 2 * d0 + hi;
            const LAS unsigned char* kp = kb + d0 * 2048 + ((r32 ^ chunk) << 4);
            const bf16x8 a0 = *(const LAS bf16x8*)kp, a1 = *(const LAS bf16x8*)(kp + 512);
            p0 = __builtin_amdgcn_mfma_f32_32x32x16_bf16(a0, qr[d0], p0, 0, 0, 0);
            p1 = __builtin_amdgcn_mfma_f32_32x32x16_bf16(a1, qr[d0], p1, 0, 0, 0);
        }
        if (MODE != 2) {
            const int dl = delta0 - 64 * t;
            if (dl < 192) {
                const int base = dl + qloc + 128;
#pragma unroll
                for (int r = 0; r < 16; ++r) { const int kl = crow(r, hi); int i0 = base - kl, i1 = base - kl - 32; i0 = i0 > 256 ? 256 : i0; i1 = i1 > 256 ? 256 : i1; p0[r] += biasL[i0]; p1[r] += biasL[i1]; }
            }
        }
        float mloc = fmaxf(p0[0], p1[0]);
#pragma unroll
        for (int r = 1; r < 16; ++r) mloc = fmaxf(mloc, fmaxf(p0[r], p1[r]));
        mloc = fmaxf(mloc, __shfl_xor(mloc, 32));
        const float mnew = fmaxf(mrun, mloc);
        const bool grew = mnew > mrun;
        const float alpha = __builtin_amdgcn_exp2f(mrun - mnew);
        mrun = mnew;
#pragma unroll
        for (int r = 0; r < 16; ++r) { p0[r] = __builtin_amdgcn_exp2f(p0[r] - mnew); p1[r] = __builtin_amdgcn_exp2f(p1[r] - mnew); }
        if (MODE == 1) {
            const u32x2 w = *(const LAS u32x2*)(bmrow + 2 * t);
            const unsigned w0 = w.x >> (4 * hi), w1 = w.y >> (4 * hi);
#pragma unroll
            for (int r = 0; r < 16; ++r) { const int bit = (r & 3) + 8 * (r >> 2);
                p0[r] = __uint_as_float(__float_as_uint(p0[r]) & (unsigned)__builtin_amdgcn_sbfe((int)w0, bit, 1));
                p1[r] = __uint_as_float(__float_as_uint(p1[r]) & (unsigned)__builtin_amdgcn_sbfe((int)w1, bit, 1)); }
        }
        float ps = 0.f;
#pragma unroll
        for (int r = 0; r < 16; ++r) ps += p0[r] + p1[r];
        lsum = lsum * alpha + ps;
        if (__any(grew)) {
            if (hi == 0) wsf[r32] = alpha;
            asm volatile("s_waitcnt lgkmcnt(0)" ::: "memory");
#pragma unroll
            for (int g = 0; g < 4; ++g) { const f32x4 a = *(const LAS f32x4*)(wsf + 8 * g + 4 * hi);
#pragma unroll
                for (int j = 0; j < 4; ++j) { o0[4 * g + j] *= a[j]; o1[4 * g + j] *= a[j]; } }
        }
        u32x4 pw[4];
        pw[0] = (u32x4){cvtpk(p0[0], p0[1]), cvtpk(p0[2], p0[3]), cvtpk(p0[4], p0[5]), cvtpk(p0[6], p0[7])};
        pw[1] = (u32x4){cvtpk(p0[8], p0[9]), cvtpk(p0[10], p0[11]), cvtpk(p0[12], p0[13]), cvtpk(p0[14], p0[15])};
        pw[2] = (u32x4){cvtpk(p1[0], p1[1]), cvtpk(p1[2], p1[3]), cvtpk(p1[4], p1[5]), cvtpk(p1[6], p1[7])};
        pw[3] = (u32x4){cvtpk(p1[8], p1[9]), cvtpk(p1[10], p1[11]), cvtpk(p1[12], p1[13]), cvtpk(p1[14], p1[15])};
#pragma unroll
        for (int ks = 0; ks < 4; ++ks) {
            const bf16x8 pa = __builtin_bit_cast(bf16x8, pw[ks]);
            const s16x4 l0 = vtr(vb + ks * 1024), h0 = vtr(vb + ks * 1024 + 512), l1 = vtr(vb + 4096 + ks * 1024), h1 = vtr(vb + 4096 + ks * 1024 + 512);
            const bf16x8 v0 = (bf16x8){l0[0], l0[1], l0[2], l0[3], h0[0], h0[1], h0[2], h0[3]}, v1 = (bf16x8){l1[0], l1[1], l1[2], l1[3], h1[0], h1[1], h1[2], h1[3]};
            o0 = __builtin_amdgcn_mfma_f32_32x32x16_bf16(pa, v0, o0, 0, 0, 0);
            o1 = __builtin_amdgcn_mfma_f32_32x32x16_bf16(pa, v1, o1, 0, 0, 0);
        }
    }
    lsum += __shfl_xor(lsum, 32);
    if (hi == 0) wsf[r32] = __builtin_amdgcn_rcpf(lsum);
    asm volatile("s_waitcnt lgkmcnt(0)" ::: "memory");
    LAS bf16* stg = (LAS bf16*)(lds + L_OST + wave * 4096);
#pragma unroll
    for (int g = 0; g < 4; ++g) { const f32x4 a = *(const LAS f32x4*)(wsf + 8 * g + 4 * hi);
#pragma unroll
        for (int j = 0; j < 4; ++j) { const int q = 8 * g + 4 * hi + j; stg[q * 64 + r32] = f2bf(o0[4 * g + j] * a[j]); stg[q * 64 + 32 + r32] = f2bf(o1[4 * g + j] * a[j]); } }
    asm volatile("s_waitcnt lgkmcnt(0)" ::: "memory");
#pragma unroll
    for (int i = 0; i < 4; ++i) {
        const int row = i * 8 + (lane >> 3), c8 = lane & 7;
        const u32x4 ov = *(const LAS u32x4*)(stg + row * 64 + c8 * 8);
        const size_t tok = (size_t)(tok0 + 32 * qh + row);
        const u32x4 gv = *(const u32x4*)(A.Gt + tok * GW + h * 64 + c8 * 8);
        u32x4 res;
#pragma unroll
        for (int e = 0; e < 4; ++e) { const float a0 = __uint_as_float(ov[e] << 16) * __uint_as_float(gv[e] << 16), a1 = __uint_as_float(ov[e] & 0xffff0000u) * __uint_as_float(gv[e] & 0xffff0000u); res[e] = cvtpk(a0, a1); }
        *(u32x4*)(A.mix + tok * D + A.colofs + h * 64 + c8 * 8) = res;
    }
}
}
namespace c1 {
typedef short bf16x8 __attribute__((ext_vector_type(8)));
typedef short s16x2 __attribute__((ext_vector_type(2)));
typedef float f32x4 __attribute__((ext_vector_type(4)));
typedef _Float16 f16x2 __attribute__((ext_vector_type(2)));
constexpr int L_HIST = 0, HSTR = 257, L_TIE = 16512, L_CTL = L_TIE + 8192  ;
__device__ __forceinline__ unsigned ord16x2(float a, float b) {
    const f16x2 hv = {(_Float16)a, (_Float16)b};
    const s16x2 x = __builtin_bit_cast(s16x2, hv);
    const s16x2 m = x >> 15;
    const s16x2 y = x ^ (m | (s16x2){(short)0x8000, (short)0x8000});
    return __builtin_bit_cast(unsigned, y);
}
__device__ __forceinline__ void scan_pass(LAS unsigned char* lds, int wave, int lane, int need_word  , int w_bin, int w_need, int w_cnt) {
    const int q = 2 * wave + (lane >> 5), l32 = lane & 31, hb = 248 - 8 * l32;
    LAS unsigned* hist = (LAS unsigned*)(lds + L_HIST) + q * HSTR + hb;
    volatile LAS unsigned* ctl = (volatile LAS unsigned*)(lds + L_CTL) + q * 8;
    unsigned cnt[8]; unsigned cs = 0;
#pragma unroll
    for (int e = 0; e < 8; ++e) { cnt[e] = hist[e]; cs += cnt[e]; hist[e] = 0u; }
    unsigned P = cs;
#pragma unroll
    for (int o = 1; o < 32; o <<= 1) { const unsigned v = __shfl_up(P, o, 32); if (l32 >= o) P += v; }
    const unsigned need = need_word < 0 ? 256u : ctl[need_word];
    if (P >= need && P - cs < need) {
        unsigned rem = need - (P - cs); int bin = hb; unsigned got = 0; bool done = false;
#pragma unroll
        for (int e = 7; e >= 0; --e) { if (!done) { if (cnt[e] >= rem) { bin = hb + e; got = cnt[e]; done = true; } else rem -= cnt[e]; } }
        ctl[w_bin] = (unsigned)bin; ctl[w_need] = rem; if (w_cnt >= 0) ctl[w_cnt] = got;
    }
}

__device__ __forceinline__ void chunk(LAS unsigned char* lds, const bf16* IQ, const bf16* IK, const float* IW, int b, int c, int tid) {
    const int wave0 = __builtin_amdgcn_readfirstlane(tid >> 6);
    const int npairs0 = 2 * (c + 1), npairs = npairs0;
    LAS unsigned* bm = (LAS unsigned*)(lds + att::L_BM);
    __syncthreads();
    if (c <= 3) { for (int i = tid; i < 64 * npairs; i += 512) bm[(i / npairs) * att::BM_STRIDE + (i % npairs)] = 0xffffffffu; __syncthreads(); return; }
    for (int i = tid; i < (L_CTL + 512) / 4; i += 512) ((LAS unsigned*)(lds + L_HIST))[i] = 0u;
    __syncthreads();
    for (int sg = 0; sg < 4; ++sg) {
        int tid_ = tid, wave = wave0, npairs = npairs0; asm volatile("" : "+v"(tid_), "+s"(wave), "+s"(npairs));
        const int lane = tid_ & 63, ql = lane & 15, kg = lane >> 4;
        LAS unsigned* histq = (LAS unsigned*)(lds + L_HIST) + ql * HSTR;
        volatile LAS unsigned* ctlq = (volatile LAS unsigned*)(lds + L_CTL) + ql * 8;
        LAS unsigned short* tieq = (LAS unsigned short*)(lds + L_TIE) + ql * 256;
        const bf16* ikb = IK + ((size_t)b * S + ql) * 64 + 8 * kg;
        const size_t tokq = (size_t)b * S + c * 64 + 16 * sg + ql;
        unsigned sk[16][4];
        {
            bf16x8 qb[8][2], qc[2]; float cw[8];
            {
                float qa[16];
#pragma unroll
                for (int e = 0; e < 16; ++e) qa[e] = 0.f;
#pragma unroll 1
                for (int h = 0; h < 8; ++h) { const float w = IW[tokq * 8 + h] * 0.02209708691207961f;
                    const bf16x8 f0 = *(const bf16x8*)(IQ + tokq * 512 + h * 64 + 8 * kg), f1 = *(const bf16x8*)(IQ + tokq * 512 + h * 64 + 32 + 8 * kg);
#pragma unroll
                    for (int j = 0; j < 8; ++j) { qa[j] += w * bf2f((bf16)f0[j]); qa[8 + j] += w * bf2f((bf16)f1[j]); } }
#pragma unroll
                for (int j = 0; j < 8; ++j) { qc[0][j] = (short)f2bf(qa[j]); qc[1][j] = (short)f2bf(qa[8 + j]); }
            }
            asm volatile("" ::: "memory");
#pragma unroll
            for (int h = 0; h < 8; ++h) { cw[h] = IW[tokq * 8 + h] * 0.02209708691207961f;
#pragma unroll
                for (int ks = 0; ks < 2; ++ks) qb[h][ks] = *(const bf16x8*)(IQ + tokq * 512 + h * 64 + 32 * ks + 8 * kg); }
            bf16x8 kA[2][2], kB[2][2];
#define C1_LOADK(dst, p_) do { _Pragma("unroll") for (int tt = 0; tt < 2; ++tt) { const bf16* kp_ = ikb + (size_t)(32 * (p_) + 16 * tt) * 64; dst[tt][0] = *(const bf16x8*)kp_; dst[tt][1] = *(const bf16x8*)(kp_ + 32); } } while (0)
#define C1_SLOT(i, cur, nxt) do { __builtin_amdgcn_sched_barrier(0); const int p = wave + 8 * (i); \
                if (p < npairs) { \
                    if (p + 8 < npairs && (i) < 15) C1_LOADK(nxt, p + 8); \
                    asm volatile("" ::: "memory"); \
                    _Pragma("unroll") for (int tt = 0; tt < 2; ++tt) { \
                        f32x4 acc = __builtin_amdgcn_mfma_f32_16x16x32_bf16(cur[tt][0], qc[0], (f32x4){0.f, 0.f, 0.f, 0.f}, 0, 0, 0); \
                        acc = __builtin_amdgcn_mfma_f32_16x16x32_bf16(cur[tt][1], qc[1], acc, 0, 0, 0); \
                        _Pragma("unroll") for (int h = 0; h < 8; ++h) { \
                            f32x4 x = __builtin_amdgcn_mfma_f32_16x16x32_bf16(cur[tt][0], qb[h][0], (f32x4){0.f, 0.f, 0.f, 0.f}, 0, 0, 0); \
                            x = __builtin_amdgcn_mfma_f32_16x16x32_bf16(cur[tt][1], qb[h][1], x, 0, 0, 0); \
                            _Pragma("unroll") for (int r = 0; r < 4; ++r) acc[r] = __builtin_fmaf(cw[h], __builtin_fabsf(x[r]), acc[r]); } \
                        sk[i][2 * tt] = ord16x2(acc[0], acc[1]); sk[i][2 * tt + 1] = ord16x2(acc[2], acc[3]); } \
                    _Pragma("unroll") for (int j = 0; j < 4; ++j) { __hip_atomic_fetch_add(histq + (sk[i][j] >> 24), 1u, __ATOMIC_RELAXED, __HIP_MEMORY_SCOPE_WORKGROUP); \
                                                  __hip_atomic_fetch_add(histq + ((sk[i][j] >> 8) & 255u), 1u, __ATOMIC_RELAXED, __HIP_MEMORY_SCOPE_WORKGROUP); } \
                    asm volatile("" ::: "memory"); \
                } else { sk[i][0] = 0u; sk[i][1] = 0u; sk[i][2] = 0u; sk[i][3] = 0u; } } while (0)
            if (wave < npairs) C1_LOADK(kA, wave);
            C1_SLOT(0, kA, kB); C1_SLOT(1, kB, kA); C1_SLOT(2, kA, kB); C1_SLOT(3, kB, kA); C1_SLOT(4, kA, kB); C1_SLOT(5, kB, kA); C1_SLOT(6, kA, kB); C1_SLOT(7, kB, kA);
            C1_SLOT(8, kA, kB); C1_SLOT(9, kB, kA); C1_SLOT(10, kA, kB); C1_SLOT(11, kB, kA); C1_SLOT(12, kA, kB); C1_SLOT(13, kB, kA); C1_SLOT(14, kA, kB); C1_SLOT(15, kB, kA);
#undef C1_SLOT
#undef C1_LOADK
        }
        __syncthreads();
        scan_pass(lds, wave, lane, -1, 0, 1, -1);
        __syncthreads();
        {
            const unsigned b1 = ctlq[0];
#pragma unroll
            for (int i = 0; i < 16; ++i) { __builtin_amdgcn_sched_barrier(0); if (wave + 8 * i < npairs) {
#pragma unroll
                for (int j = 0; j < 4; ++j) { const unsigned v = sk[i][j];
                    if ((v >> 24) == b1) __hip_atomic_fetch_add(histq + ((v >> 16) & 255u), 1u, __ATOMIC_RELAXED, __HIP_MEMORY_SCOPE_WORKGROUP);
                    if (((v >> 8) & 255u) == b1) __hip_atomic_fetch_add(histq + (v & 255u), 1u, __ATOMIC_RELAXED, __HIP_MEMORY_SCOPE_WORKGROUP); } } }
        }
        __syncthreads();
        scan_pass(lds, wave, lane, 1, 2, 3, 5);
        if (tid < 16) ((volatile LAS unsigned*)(lds + L_CTL))[tid * 8 + 4] = 0u;
        __syncthreads();
        const unsigned T16 = (ctlq[0] << 8) | ctlq[2], need2 = ctlq[3];
        {
#pragma unroll
            for (int i = 0; i < 16; ++i) { __builtin_amdgcn_sched_barrier(0); const int p = wave + 8 * i; if (p < npairs) {
#pragma unroll
                for (int j = 0; j < 4; ++j) { const unsigned v = sk[i][j]; const int idx0 = 32 * p + 16 * (j >> 1) + 4 * kg + 2 * (j & 1);
                    if ((v & 0xffffu) == T16) { const unsigned s = __hip_atomic_fetch_add((LAS unsigned*)(ctlq + 4), 1u, __ATOMIC_RELAXED, __HIP_MEMORY_SCOPE_WORKGROUP); if (s < 256u) tieq[s] = (unsigned short)idx0; }
                    if ((v >> 16) == T16) { const unsigned s = __hip_atomic_fetch_add((LAS unsigned*)(ctlq + 4), 1u, __ATOMIC_RELAXED, __HIP_MEMORY_SCOPE_WORKGROUP); if (s < 256u) tieq[s] = (unsigned short)(idx0 + 1); } } } }
        }
        __syncthreads();
        {
            unsigned ntie = ctlq[4]; ntie = ntie > 256u ? 256u : ntie;
            const bool all_ties = ctlq[5] <= need2;
#pragma unroll
            for (int i = 0; i < 16; ++i) { __builtin_amdgcn_sched_barrier(0); const int p = wave + 8 * i; if (p < npairs) {
                unsigned word = 0u;
#pragma unroll
                for (int j = 0; j < 4; ++j) { const unsigned v = sk[i][j];
#pragma unroll
                    for (int hf = 0; hf < 2; ++hf) { const unsigned k16 = hf ? (v >> 16) : (v & 0xffffu); const int bit = 16 * (j >> 1) + 4 * kg + 2 * (j & 1) + hf;
                        bool sel = k16 > T16;
                        if (k16 == T16) { if (all_ties) sel = true; else { const unsigned idx = 32 * p + bit; unsigned rank = 0; for (unsigned e = 0; e < ntie; ++e) rank += (tieq[e] < idx) ? 1u : 0u; sel = rank < need2; } }
                        word |= sel ? (1u << bit) : 0u; } }
                word |= __shfl_xor(word, 16); word |= __shfl_xor(word, 32);
                if (kg == 0) bm[(16 * sg + ql) * att::BM_STRIDE + p] = word; } }
        }
        __syncthreads();
    }
}
}
constexpr int RING_OFF = 0, RING_BYTES = 131072;
constexpr int LDSCTL_OFF = 147456 - 1024, MISC_OFF = LDSCTL_OFF + 320;
constexpr int SCR_OFF = 138240;
constexpr int LDS_BYTES = 147456;
constexpr int NWAVES = 8;

struct Args { const float* in[17]; float* out; unsigned char* ws; };

__device__ __forceinline__ void transpose_item(const float* W, int N, bf16* WT, bool perm, LAS float* scr, int item, int lane) {
    const int nblk = (N + 31) / 32, kb = item / nblk, nb = item % nblk, k0 = 64 * kb, n0 = 32 * nb;
    const bool nok = n0 + (lane & 31) < N;
#pragma unroll 8
    for (int i = 0; i < 32; ++i) { const int kk = 2 * i + (lane >> 5); scr[kk * 33 + (lane & 31)] = nok ? W[(size_t)(k0 + kk) * N + n0 + (lane & 31)] : 0.f; }
    asm volatile("s_waitcnt lgkmcnt(0)" ::: "memory");
    const int c = lane & 7;
#pragma unroll
    for (int j = 0; j < 4; ++j) { const int n = (lane >> 3) + 8 * j; const LAS float* s = scr + (8 * c) * 33 + n;
        if (n0 + n < N) {
            v4u o; o.x = pk2(s[0 * 33], s[1 * 33]); o.y = pk2(s[2 * 33], s[3 * 33]); o.z = pk2(s[4 * 33], s[5 * 33]); o.w = pk2(s[6 * 33], s[7 * 33]);
            const int drow = perm ? perm_col(n0 + n) : (n0 + n);
            *(GAS v4u*)(WT + (size_t)drow * 1024 + k0 + 8 * c) = o; } }
    asm volatile("s_waitcnt lgkmcnt(0)" ::: "memory");
}
__device__ __forceinline__ void ln_row(const float* in, float* out, bf16* outb, const float* g, const float* b, int lane) {
    const f32x4* xr = (const f32x4*)in + lane;
    f32x4 v[4]; float s = 0.f;
#pragma unroll
    for (int j = 0; j < 4; ++j) { v[j] = xr[64 * j]; s += (v[j].x + v[j].y) + (v[j].z + v[j].w); }
    const float mean = wave_sum(s) * (1.f / D); float s2 = 0.f;
#pragma unroll
    for (int j = 0; j < 4; ++j) { v[j] = v[j] - mean; s2 += (v[j].x * v[j].x + v[j].y * v[j].y) + (v[j].z * v[j].z + v[j].w * v[j].w); }
    const float rstd = rsqrtf(wave_sum(s2) * (1.f / D) + LN_EPS);
#pragma unroll
    for (int j = 0; j < 4; ++j) {
        const int c = 4 * (lane + 64 * j);
        const f32x4 o = v[j] * rstd * *(const f32x4*)(g + c) + *(const f32x4*)(b + c);
        *(f32x4*)(out + c) = o;
        *(unsigned long long*)(outb + c) = (unsigned long long)pk2(o.x, o.y) | ((unsigned long long)pk2(o.z, o.w) << 32);
    }
}
__device__ __forceinline__ void memkv_tile(const float* A, const float* W, bf16* km, bf16* vm, int tm, int tn, LAS float* As, LAS float* Bs, int tid) {
    const int tx = tid & 15, ty = tid >> 4, m0 = tm * 128, n0 = tn * 64;
    float acc[4][4];
#pragma unroll
    for (int i = 0; i < 4; ++i)
#pragma unroll
        for (int j = 0; j < 4; ++j) acc[i][j] = 0.f;
    for (int k0 = 0; k0 < D; k0 += 16) {
#pragma unroll
        for (int i = 0; i < 4; ++i) { const int e = tid + 512 * i, r = e >> 4, kk = e & 15; As[kk * 129 + r] = A[(size_t)(m0 + r) * D + k0 + kk]; }
#pragma unroll
        for (int i = 0; i < 2; ++i) { const int e = tid + 512 * i, kk = e >> 6, c = e & 63; Bs[kk * 65 + c] = W[(size_t)(k0 + kk) * 512 + n0 + c]; }
        __syncthreads();
#pragma unroll
        for (int kk = 0; kk < 16; ++kk) {
            float a[4], b[4];
#pragma unroll
            for (int i = 0; i < 4; ++i) { a[i] = As[kk * 129 + ty * 4 + i]; b[i] = Bs[kk * 65 + tx * 4 + i]; }
#pragma unroll
            for (int i = 0; i < 4; ++i)
#pragma unroll
                for (int j = 0; j < 4; ++j) acc[i][j] += a[i] * b[j];
        }
        __syncthreads();
    }
#pragma unroll
    for (int i = 0; i < 4; ++i)
#pragma unroll
        for (int j = 0; j < 4; ++j) { const int row = m0 + ty * 4 + i, col = n0 + tx * 4 + j;
            if (col < 256) km[(size_t)row * 256 + col] = f2bf(acc[i][j]); else vm[(size_t)row * 256 + col - 256] = f2bf(acc[i][j]); }
}

__device__ __forceinline__ void mixer_a_unit(int blk, const bf16* au, const bf16* av, const bf16* ag, const float* lng, const float* lnb, const float* ws_, const float* bs, bf16* mix, LAS float* vt, int tid) {
    const int wave = tid >> 6, lane = tid & 63;
    const size_t row0 = (size_t)blk * 128;
    for (int r = wave; r < 128; r += NWAVES) {
        const bf16* p = av + (row0 + r) * GW + lane * 4;
        float v[4]; float s = 0.f;
#pragma unroll
        for (int j = 0; j < 4; ++j) { v[j] = bf2f(p[j]); s += v[j]; }
        const float mean = wave_sum(s) * (1.f / GW); float s2 = 0.f;
#pragma unroll
        for (int j = 0; j < 4; ++j) { v[j] -= mean; s2 += v[j] * v[j]; }
        const float rstd = rsqrtf(wave_sum(s2) * (1.f / GW) + LN_EPS);
#pragma unroll
        for (int j = 0; j < 4; ++j) vt[r * 256 + lane * 4 + j] = bf2f(f2bf(v[j] * rstd * lng[lane * 4 + j] + lnb[lane * 4 + j]));
    }
    __syncthreads();
    const int ch = tid & 255, g = ch >> 6;
    for (int i = tid >> 8; i < 128; i += 2) {
        const float* wr = ws_ + ((size_t)g * 128 + i) * 128;
        const int jmax = i < 64 ? 64 : 128;
        float acc = 0.f;
        for (int j = 0; j < jmax; ++j) acc += wr[j] * vt[j * 256 + ch];
        acc += bs[g * 128 + i];
        const size_t idx = (row0 + i) * GW + ch;
        mix[(row0 + i) * D + ch] = f2bf(bf2f(au[idx]) * acc * bf2f(ag[idx]));
    }
    __syncthreads();
}
template <int MODE>
__device__ __forceinline__ void attn_wave(int token, int h, const bf16* Q, const bf16* K, const bf16* V, const bf16* G, bf16* mix, int colofs, const float* tbl,
                                          LAS float* sc, LAS float* qs, const LAS unsigned* keys, unsigned Tv, int Ti, int lane, float qscale = 1.f, const unsigned* bmg = nullptr) {
    const int b = token / S, pos = token % S, c = pos >> 6;
    int k0, k1; size_t kbase;
    if (MODE == 0) { k0 = (c >= 8 ? c - 8 : 0) * 64; k1 = (c + 1) * 64; kbase = (size_t)b * S; }
    else if (MODE == 1 || MODE == 3) { k0 = 0; k1 = (c + 1) * 64; kbase = (size_t)b * S; }
    else { k0 = 0; k1 = NMEM; kbase = (size_t)b * NMEM; }
    qs[lane] = bf2f(Q[(size_t)token * GW + h * 64 + lane]);
    asm volatile("s_waitcnt lgkmcnt(0)" ::: "memory");
    float mx = -INFINITY;
    for (int key = k0 + lane; key < k1; key += 64) {
        const bf16* kr = K + (kbase + key) * GW + h * 64;
        float s = 0.f;
#pragma unroll 8
        for (int d = 0; d < 64; ++d) s += qs[d] * bf2f(kr[d]);
        s *= qscale;
        if (MODE != 2) { int dd = pos - key; dd = dd < -128 ? -128 : (dd > 128 ? 128 : dd); s += tbl[h * 257 + dd + 128]; }
        if (MODE == 1) { const unsigned kv = keys[key]; if (!(kv > Tv || (kv == Tv && key <= Ti))) s = -INFINITY; }
        if (MODE == 3) { if (!((bmg[(size_t)token * 128 + (key >> 5)] >> (key & 31)) & 1u)) s = -INFINITY; }
        sc[key - k0] = s; mx = fmaxf(mx, s);
    }
    mx = wave_max(mx);
    float sum = 0.f;
    for (int key = k0 + lane; key < k1; key += 64) { const float p = __expf(sc[key - k0] - mx); sc[key - k0] = p; sum += p; }
    sum = wave_sum(sum);
    asm volatile("s_waitcnt lgkmcnt(0)" ::: "memory");
    float o = 0.f;
    for (int key = k0; key < k1; ++key) { const float p = sc[key - k0]; if (p != 0.f) o += p * bf2f(V[(kbase + key) * GW + h * 64 + lane]); }
    o /= sum;
    mix[(size_t)token * D + colofs + h * 64 + lane] = f2bf(o * bf2f(G[(size_t)token * GW + h * 64 + lane]));
    asm volatile("s_waitcnt lgkmcnt(0)" ::: "memory");
}
__device__ __forceinline__ int block_sum_i(int v, volatile LAS int* red, int tid) {
#pragma unroll
    for (int o = 1; o < 64; o <<= 1) v += __shfl_xor(v, o);
    __syncthreads();
    if ((tid & 63) == 0) red[tid >> 6] = v;
    __syncthreads();
    int s = 0;
#pragma unroll
    for (int w = 0; w < NWAVES; ++w) s += red[w];
    return s;
}
__device__ __forceinline__ void mixer_c_token(int token, const bf16* IQ, const bf16* IK, const float* IW, const bf16* Q, const bf16* K, const bf16* V, const bf16* G, bf16* mix, const float* tbl,
                                              LAS unsigned char* lds, int tid, float qscale = 1.f, const unsigned* bmg = nullptr, float* dacc = nullptr) {
    LAS unsigned* keys = (LAS unsigned*)(lds + RING_OFF);
    LAS float* qh = (LAS float*)(lds + SCR_OFF + 4096);
    LAS float* wq = (LAS float*)(lds + SCR_OFF + 4096 + 2048);
    volatile LAS int* red = (volatile LAS int*)(lds + SCR_OFF + 4096 + 2048 + 64);
    const int wave = tid >> 6, lane = tid & 63;
    const int b = token / S, pos = token % S, c = pos >> 6, n = (c + 1) * 64;
    qh[tid] = bf2f(IQ[(size_t)token * 512 + tid]);
    if (tid < 8) wq[tid] = IW[(size_t)token * 8 + tid] * 0.35355339059327373f;
    __syncthreads();
    for (int key = tid; key < n; key += 512) {
        const bf16* kr = IK + ((size_t)b * S + key) * 64;
        float score = 0.f;
        for (int h = 0; h < 8; ++h) {
            float s = 0.f;
#pragma unroll 8
            for (int d = 0; d < 64; ++d) s += qh[h * 64 + d] * bf2f(kr[d]);
            s *= 0.125f;
            score += fmaxf(s, 0.f) * wq[h];
        }
        const unsigned u = __float_as_uint(score);
        keys[key] = (u & 0x80000000u) ? ~u : (u | 0x80000000u);
    }
    __syncthreads();
    unsigned Tv = 0u; int Ti = 4095;
    if (n > 256) {
        unsigned prefix = 0u;
        for (int bit = 31; bit >= 0; --bit) {
            const unsigned cand = prefix | (1u << bit);
            int cnt = 0;
            for (int key = tid; key < n; key += 512) cnt += (keys[key] >= cand) ? 1 : 0;
            cnt = block_sum_i(cnt, red, tid);
            if (cnt >= 256) prefix = cand;
        }
        Tv = prefix;
        int cgt = 0;
        for (int key = tid; key < n; key += 512) cgt += (keys[key] > Tv) ? 1 : 0;
        cgt = block_sum_i(cgt, red, tid);
        const int r = 256 - cgt;
        int I = 0;
        for (int bit = 11; bit >= 0; --bit) {
            const int cand = I | (1 << bit);
            int cnt = 0;
            for (int key = tid; key < n; key += 512) cnt += (keys[key] == Tv && key < cand) ? 1 : 0;
            cnt = block_sum_i(cnt, red, tid);
            if (cnt < r) I = cand;
        }
        Ti = I;
    }
    if (bmg) {
        if (tid < 128) { unsigned w = 0u; const int lo = tid * 32;
            if (lo < n) { if (n <= 256) w = 0xffffffffu; else for (int j = 0; j < 32; ++j) { const unsigned kv = keys[lo + j]; if (kv > Tv || (kv == Tv && lo + j <= Ti)) w |= 1u << j; } }
            const unsigned o = lo < n ? bmg[(size_t)token * 128 + tid] : 0u;
            float dx = (float)__popc(w ^ o), dr = (float)__popc(w); dx = wave_sum(dx); dr = wave_sum(dr);
            if (lane == 0) { atomicAdd(dacc + 8, dx); atomicAdd(dacc + 9, dr); } }
        if (wave < 4) attn_wave<3>(token, wave, Q, K, V, G, mix, 512, tbl, (LAS float*)(lds + RING_OFF + 16384 + wave * 16384), (LAS float*)(lds + SCR_OFF + wave * 256), keys, Tv, Ti, lane, qscale, bmg);
    } else if (wave < 4) attn_wave<1>(token, wave, Q, K, V, G, mix, 512, tbl, (LAS float*)(lds + RING_OFF + 16384 + wave * 16384), (LAS float*)(lds + SCR_OFF + wave * 256), keys, Tv, Ti, lane, qscale);
    __syncthreads();
}

template <int OFF> __device__ __forceinline__ unsigned long long karg_u64() {
    const __attribute__((address_space(4))) char* k = (const __attribute__((address_space(4))) char*)__builtin_amdgcn_kernarg_segment_ptr();
    unsigned long long v;
    asm volatile("s_load_dwordx2 %0, %1, %2\n\ts_waitcnt lgkmcnt(0)" : "=s"(v) : "s"(k), "i"(OFF) : "memory");
    return v;
}
#define IN_PTR(i) ((const float*)karg_u64<8 * (i)>())
#define OUT_PTR() ((float*)karg_u64<8 * 17>())
#define WS_PTR() ((unsigned char*)karg_u64<8 * 18>())
#define GRP(g) ((bf16*)(WS_PTR() + WS_P13) + (size_t)(g) * T * GW)
#define GRID_BAR() do { XcdBarrier b_; b_.bar = (unsigned*)((gu32*)(WS_PTR() + WS_CTL) + CW_BAR); b_.x = xb_xcc_id(); b_.st = (volatile LAS unsigned*)((LAS unsigned char*)lds_raw + MISC_OFF) + 8; xcd_barrier(b_); } while (0)

__global__ void __launch_bounds__(NWAVES * 64, 2) mk_fwd(Args args) {
    extern __shared__ __attribute__((aligned(16))) unsigned char lds_raw[];
    {
        LAS unsigned char* lds = (LAS unsigned char*)lds_raw;
        for (int u = threadIdx.x; u < (LDS_BYTES - LDSCTL_OFF) / 4; u += NWAVES * 64) ((LAS unsigned*)(lds + LDSCTL_OFF))[u] = 0u;
        __syncthreads();
        (void)xcd_barrier_post((unsigned*)((gu32*)(WS_PTR() + WS_CTL) + CW_BAR), (volatile LAS unsigned*)(lds + MISC_OFF) + 8);
    }
    {
        LAS unsigned char* lds = (LAS unsigned char*)lds_raw;
        const int tid = threadIdx.x, lane = tid & 63, wave = __builtin_amdgcn_readfirstlane(tid >> 6);
        const int G = gridDim.x, bx = blockIdx.x, vcu = (G % 8 == 0) ? (bx % 8) * (G / 8) + bx / 8 : bx;
        const int gw = vcu * NWAVES + wave, NGW = G * NWAVES;
        unsigned char* ws = WS_PTR();
        const float* w_in = IN_PTR(4); const float* w_out = IN_PTR(13);
        bf16* WIN = (bf16*)(ws + WS_WIN); bf16* WOUT = (bf16*)(ws + WS_WOUT);
        float* tbl = (float*)(ws + WS_TBL); float* bperm = (float*)(ws + WS_TBL + 65536);
        LAS float* scr = (LAS float*)(lds + RING_OFF + wave * 16384);
        constexpr int I_IN = 16 * 123, I_OUT = 16 * 32;
        for (int it = gw; it < 2 * I_IN + 2 * I_OUT; it += NGW) {
            int r = it;
            if (r < 2 * I_IN) { const int l = r / I_IN; transpose_item(w_in + (size_t)l * D * DIN, DIN, WIN + (size_t)l * DINP * D, true, scr, r % I_IN, lane); }
            else { r -= 2 * I_IN; const int l = r / I_OUT; transpose_item(w_out + (size_t)l * D * D, D, WOUT + (size_t)l * D * D, false, scr, r % I_OUT, lane); }
        }
        { const float* b_in = IN_PTR(5);
          for (int i = bx * 512 + tid; i < 2 * DINP; i += G * 512) { const int l = i / DINP, p = i % DINP; int col = -1;
              if (p < 3328) col = p; else if (p < 3584) col = 3400 + (p - 3328); else if (p < 3840) col = 3656 + (p - 3584); else if (p < 3904) col = 3328 + (p - 3840); else if (p < 3912) col = 3392 + (p - 3904);
              bperm[i] = col >= 0 ? b_in[l * DIN + col] : 0.f; } }
        { const float* t5 = IN_PTR(11);
          for (int i = bx * 512 + tid; i < 4 * 257; i += G * 512) {
            const int h = i / 257, d = i % 257 - 128, rel = -d, n = rel < 0 ? -rel : rel;
            int bucket = rel > 0 ? 16 : 0;
            if (n < 8) bucket += n; else { int large = 8 + (31 - __clz(n * n)) - 6; if (large > 15) large = 15; bucket += large; }
            tbl[i] = t5[bucket * 4 + h];
          } }
        { const float* x = IN_PTR(0); float* out = OUT_PTR(); bf16* HB = (bf16*)(ws + WS_HB); const float* g = IN_PTR(2); const float* b = IN_PTR(3);
          for (int m = gw; m < T; m += NGW) ln_row(x + (size_t)m * D, out + (size_t)m * D, HB + (size_t)m * D, g, b, lane); }
        __syncthreads();
        {
            const float* mem = IN_PTR(1); const float* w_mem = IN_PTR(12);
            LAS float* As = (LAS float*)(lds + RING_OFF); LAS float* Bs = As + 16 * 129;
            for (int it = bx; it < 256; it += G) { const int l = it >> 7, tt = it & 127;
                memkv_tile(mem, w_mem + (size_t)l * D * 512, (bf16*)(ws + WS_KM) + (size_t)l * NB * NMEM * 256, (bf16*)(ws + WS_VM) + (size_t)l * NB * NMEM * 256, tt >> 3, tt & 7, As, Bs, tid); }
        }
    }
    GRID_BAR();

    for (int l = 0; l < 2; ++l) {
#ifndef NO_P1
        {
            unsigned char* ws = WS_PTR();
            pg8::Gemm g{(const bf16*)(ws + WS_HB), (const bf16*)(ws + WS_WIN) + (size_t)l * DINP * D, T, DINP, D}; pg8::StaticOrder SO; SO.init(T, DINP, gridDim.x, blockIdx.x);
            pg8::EpiRoute E{(bf16*)(ws + WS_P13), (bf16*)(ws + WS_IQ), (bf16*)(ws + WS_IK), (float*)(ws + WS_IW), (const float*)(ws + WS_TBL + 65536) + l * DINP};
            pg8::gemm_phase<pg8::EpiRoute, pg8::StaticOrder, true, true>((LAS unsigned char*)lds_raw + RING_OFF, g, SO, E);
        }
#endif
        GRID_BAR();
#ifndef NO_P2
        {
            LAS unsigned char* lds = (LAS unsigned char*)lds_raw;
            int tid_ = threadIdx.x, G_ = gridDim.x, bx_ = blockIdx.x; asm volatile("" : "+v"(tid_), "+s"(G_), "+s"(bx_));
            const int tid = tid_, lane = tid & 63, wave = __builtin_amdgcn_readfirstlane(tid >> 6);
            const int G = G_, bx = bx_, vcu = (G % 8 == 0) ? (bx % 8) * (G / 8) + bx / 8 : bx;
            const int gw = vcu * NWAVES + wave, NGW = G * NWAVES;
            unsigned char* ws = WS_PTR();
            bf16* MIX = (bf16*)(ws + WS_MIX);
            const bf16* KM = (const bf16*)(ws + WS_KM) + (size_t)l * NB * NMEM * 256; const bf16* VM = (const bf16*)(ws + WS_VM) + (size_t)l * NB * NMEM * 256;
            for (int blk = bx; blk < T / 128; blk += G)
                mixer_a_unit(blk, GRP(G_AU), GRP(G_AV), GRP(G_AG), IN_PTR(6) + l * GW, IN_PTR(7) + l * GW, IN_PTR(8) + (size_t)l * 4 * 128 * 128, IN_PTR(9) + l * 4 * 128, MIX, (LAS float*)(lds + RING_OFF), tid);
            __syncthreads();
            {
                att::fill_bias(lds, IN_PTR(10) + (size_t)l * 4 * 257, tid);
                att::Cfg cfg{GRP(G_BQ), GRP(G_BK), GRP(G_BV), GRP(G_BG), MIX, 256};
                for (int u = vcu; u < NB * 64; u += G) { const int b = u >> 6, c = u & 63, kt0 = c >= 8 ? c - 8 : 0;
                    att::unit<0>(lds, cfg, b * S + c * 64, (size_t)b * S + kt0 * 64, c - kt0 + 1, (c - kt0) * 64, tid); }
            }
            {
                att::Cfg cfg{GRP(G_MQ), KM, VM, GRP(G_MG), MIX, 768};
                for (int u = vcu; u < NB * 64; u += G) { const int b = u >> 6, c = u & 63;
                    att::unit<2>(lds, cfg, b * S + c * 64, (size_t)b * NMEM, NMEM / 64, 0, tid); }
            }
#ifdef DEBUG_CMP
            if (l == 0) {
                __syncthreads();
                bf16* MIXR = (bf16*)(ws + 406 * MiB);
                LAS float* sc = (LAS float*)(lds + RING_OFF + wave * 16384); LAS float* qs = (LAS float*)(lds + SCR_OFF + wave * 256);
                const float* brel = IN_PTR(10);
                for (int it = gw; it < T * 4; it += NGW) attn_wave<0>(it >> 2, it & 3, GRP(G_BQ), GRP(G_BK), GRP(G_BV), GRP(G_BG), MIXR, 256, brel, sc, qs, nullptr, 0u, 0, lane, 0.6931471805599453f);
                for (int it = gw; it < T * 4; it += NGW) attn_wave<2>(it >> 2, it & 3, GRP(G_MQ), KM, VM, GRP(G_MG), MIXR, 768, nullptr, sc, qs, nullptr, 0u, 0, lane, 0.6931471805599453f);
            }
#endif
            __syncthreads();
            {
                att::fill_bias(lds, (const float*)(ws + WS_TBL), tid);
                att::Cfg cfg{GRP(G_CQ), GRP(G_CK), GRP(G_CV), GRP(G_CG), MIX, 512};
                for (int u = vcu; u < NB * 32; u += G) { const int b = u >> 5, j = u & 31;
                    for (int side = 0; side < 2; ++side) { const int c = side ? 63 - j : j;
                        c1::chunk(lds, (const bf16*)(ws + WS_IQ), (const bf16*)(ws + WS_IK), (const float*)(ws + WS_IW), b, c, tid);
#ifdef DEBUG_CMP
                        if (l == 0) { unsigned* bmg = (unsigned*)(ws + 470 * MiB); const LAS unsigned* bml = (const LAS unsigned*)(lds + att::L_BM);
                            for (int i = tid; i < 64 * 128; i += 512) { const int q = i >> 7, w = i & 127; bmg[((size_t)b * S + c * 64 + q) * 128 + w] = w < 2 * (c + 1) ? bml[q * att::BM_STRIDE + w] : 0u; } }
#endif
                        att::unit<1>(lds, cfg, b * S + c * 64, (size_t)b * S, c + 1, c * 64, tid); } }
            }
        }
#endif
        GRID_BAR();
#ifdef DEBUG_CMP
        if (l == 0) {
            int tid_ = threadIdx.x, G_ = gridDim.x, bx_ = blockIdx.x; asm volatile("" : "+v"(tid_), "+s"(G_), "+s"(bx_));
            const int tid = tid_, lane = tid & 63, wave = __builtin_amdgcn_readfirstlane(tid >> 6);
            const int G = G_, bx = bx_, vcu = (G % 8 == 0) ? (bx % 8) * (G / 8) + bx / 8 : bx;
            const int gw = vcu * NWAVES + wave, NGW = G * NWAVES;
            unsigned char* ws = WS_PTR(); const bf16* MIX = (const bf16*)(ws + WS_MIX); bf16* MIXR = (bf16*)(ws + 406 * MiB);
            {   LAS unsigned char* lds = (LAS unsigned char*)lds_raw;
                for (int token = bx; token < T; token += G) mixer_c_token(token, (const bf16*)(ws + WS_IQ), (const bf16*)(ws + WS_IK), (const float*)(ws + WS_IW), GRP(G_CQ), GRP(G_CK), GRP(G_CV), GRP(G_CG), MIXR, (const float*)(ws + WS_TBL), lds, tid,
                                                                          0.6931471805599453f, (const unsigned*)(ws + 470 * MiB), (float*)(ws + WS_CTL) + 2048); }
            GRID_BAR();
                float* acc = (float*)(ws + WS_CTL) + 2048;
                for (int seg = 1; seg < 4; ++seg) {
                    float sd = 0.f, sr = 0.f;
                    for (int m = gw; m < T; m += NGW) for (int j = 0; j < 4; ++j) { const size_t idx = (size_t)m * D + seg * 256 + lane * 4 + j; const float a = bf2f(MIX[idx]), r = bf2f(MIXR[idx]); sd += (a - r) * (a - r); sr += r * r; }
                    sd = wave_sum(sd); sr = wave_sum(sr);
                    if (lane == 0) { atomicAdd(acc + 2 * seg, sd); atomicAdd(acc + 2 * seg + 1, sr); }
                }
        }
#endif
#ifndef NO_P3
        {
            unsigned char* ws = WS_PTR();
            pg8::Gemm g{(const bf16*)(ws + WS_MIX), (const bf16*)(ws + WS_WOUT) + (size_t)l * D * D, T, D, D}; pg8::StaticOrder SO; SO.init(T, D, gridDim.x, blockIdx.x);
            pg8::EpiResid E{OUT_PTR(), IN_PTR(14) + l * D};
            pg8::gemm_phase<pg8::EpiResid, pg8::StaticOrder, true, true>((LAS unsigned char*)lds_raw + RING_OFF, g, SO, E);
        }
#endif
        GRID_BAR();
        {
            int tid_ = threadIdx.x, G_ = gridDim.x, bx_ = blockIdx.x; asm volatile("" : "+v"(tid_), "+s"(G_), "+s"(bx_));
            const int tid = tid_, lane = tid & 63, wave = __builtin_amdgcn_readfirstlane(tid >> 6);
            const int G = G_, bx = bx_, vcu = (G % 8 == 0) ? (bx % 8) * (G / 8) + bx / 8 : bx;
            const int gw = vcu * NWAVES + wave, NGW = G * NWAVES;
            float* out = OUT_PTR(); bf16* HB = (bf16*)(WS_PTR() + WS_HB); const float* g = IN_PTR(15) + l * D; const float* b = IN_PTR(16) + l * D;
            for (int m = gw; m < T; m += NGW) ln_row(out + (size_t)m * D, out + (size_t)m * D, HB + (size_t)m * D, g, b, lane);
        }
        if (l == 0) GRID_BAR();
    }
#ifdef DEBUG_CMP
    GRID_BAR();
    if (blockIdx.x == 0 && threadIdx.x < 5) { const float* acc = (const float*)(WS_PTR() + WS_CTL) + 2048; const int seg = threadIdx.x; const float sd = acc[2 * seg], sr = acc[2 * seg + 1];
        if (sr > 0.f) OUT_PTR()[seg] = 1000.f * sqrtf(sd / sr); }
#endif
}

extern "C" void kernel_launch(void* const* d_in, const int* in_sizes, int n_in, void* d_out, int out_size, void* d_ws, size_t ws_size, hipStream_t stream) {
    static int grid = 0;
    if (grid == 0) {
        if (n_in != 17 || out_size != T * D || ws_size < WS_END) { fprintf(stderr, "kernel_launch: unexpected n_in %d / out_size %d / ws_size %zu; nothing launched\n", n_in, out_size, ws_size); grid = -1; return; }
        int dev = 0, cus = 0, per_cu = 0;
        if (hipGetDevice(&dev) != hipSuccess || hipDeviceGetAttribute(&cus, hipDeviceAttributeMultiprocessorCount, dev) != hipSuccess) { grid = -1; return; }
        if (hipFuncSetAttribute((const void*)mk_fwd, hipFuncAttributeMaxDynamicSharedMemorySize, LDS_BYTES) != hipSuccess) { fprintf(stderr, "kernel_launch: hipFuncSetAttribute failed\n"); grid = -1; return; }
        if (hipOccupancyMaxActiveBlocksPerMultiprocessor(&per_cu, (const void*)mk_fwd, NWAVES * 64, LDS_BYTES) != hipSuccess || per_cu < 1) { fprintf(stderr, "kernel_launch: occupancy query says %d blocks per CU; nothing launched\n", per_cu); (void)hipGetLastError(); grid = -1; return; }
        grid = cus;
    }
    if (grid < 0) return;
    if (hipMemsetAsync((char*)d_ws + WS_CTL, 0, CTL_ZERO_BYTES, stream) != hipSuccess) { fprintf(stderr, "kernel_launch: memset failed\n"); return; }
    Args a{};
    for (int i = 0; i < 17; ++i) a.in[i] = (const float*)d_in[i];
    a.out = (float*)d_out; a.ws = (unsigned char*)d_ws;
    hipLaunchKernelGGL(mk_fwd, dim3(grid), dim3(NWAVES * 64), LDS_BYTES, stream, a);
}
```

```cpp
#include <hip/hip_runtime.h>
#include <cstdio>
#include <cstdint>
namespace pg8 {
#define PG8_LAS __attribute__((address_space(3)))
typedef unsigned short bf16_t;
typedef short bf16x8 __attribute__((ext_vector_type(8)));
typedef float f32x4 __attribute__((ext_vector_type(4)));
typedef unsigned u32x4 __attribute__((ext_vector_type(4)));
constexpr int BM = 256, BK = 64, HALF = 128, HTB = HALF * BK * 2  , STAGE_BYTES = 8 * HTB, NXCD = 8, WGM = 8;

__host__ __device__ __forceinline__ int lds_byte(int r, int c) { const int st = (r >> 4) * 2 + (c >> 5), rr = r & 15, cc = c & 31, ob = rr * 64 + cc * 2; return st * 1024 + (ob ^ (((ob >> 9) & 1) << 5)); }
__host__ __device__ __forceinline__ void stage_rc(int b, int& R, int& C) { const int st = b / 1024, sb = b % 1024, swz = sb ^ (((sb >> 9) & 1) << 5); R = (st >> 1) * 16 + swz / 64; C = (st & 1) * 32 + (swz % 64) / 2; }
__host__ __device__ __forceinline__ int perm32(int rho) { const int n = rho >> 4, i = rho & 15; return 8 * (i >> 2) + 4 * n + (i & 3); }

struct Unit { int pm, pn; };
struct Gemm { const bf16_t* A; const bf16_t* Bt; int M, N, K; };

struct StaticOrder {
    int nM, nN, nwg, G, c;
    __host__ __device__ void init(int M, int N, int G_, int c_) { nM = M / BM; nN = N / BM; nwg = nM * nN; G = G_; c = c_; }
    __host__ __device__ bool next(int i, Unit& u) const {
        const long L = (long)i * G + c; if (L >= nwg) return false;
        int wgid = (int)L; { const int q = nwg / NXCD, r = nwg % NXCD, xcd = wgid % NXCD, off = wgid / NXCD; wgid = (xcd < r ? xcd * (q + 1) : r * (q + 1) + (xcd - r) * q) + off; }
        const int nig = WGM * nN, gid = wgid / nig, fm = gid * WGM, gsz = (nM - fm) < WGM ? (nM - fm) : WGM;
        u.pm = fm + ((wgid % nig) % gsz); u.pn = (wgid % nig) / gsz; return true;
    }
    __device__ __forceinline__ void a_ready(const Unit&) const {}
    __device__ __forceinline__ void done(const Unit&) const {}
};

__device__ __forceinline__ unsigned cvt_pk_bf16(float lo, float hi) { unsigned r; asm volatile("v_cvt_pk_bf16_f32 %0, %1, %2" : "=v"(r) : "v"(lo), "v"(hi)); return r; }
typedef float f32x2 __attribute__((ext_vector_type(2)));
template <class Epi, class Sched, bool ALIGN_EPI = false, bool SP2 = false>
__device__ __forceinline__ void gemm_phase(PG8_LAS unsigned char* lds, const Gemm g, const Sched& S, const Epi& E) {
    const int tid = threadIdx.x, wid = __builtin_amdgcn_readfirstlane(tid >> 6), lane = tid & 63, wr = wid >> 2, wc = wid & 3, fr = lane & 15, fq = lane >> 4;
    const int K = g.K, nt = K / BK;
    unsigned voffA[2], voffB[2];
#pragma unroll
    for (int i = 0; i < 2; ++i) { int R, C; stage_rc(tid * 16 + i * 8192, R, C); const int Rb = Epi::PERM ? ((R & ~31) + perm32(R & 31)) : R;
        voffA[i] = (unsigned)(R * K + C) * 2u; voffB[i] = (unsigned)(Rb * K + C) * 2u; }
    const size_t kstep = (size_t)(BK * 2);
    const size_t hstep = (size_t)HALF * K * 2;
    const size_t tstep = 2 * hstep;
    const unsigned ldsw = (unsigned)wid * 1024u;
    const int aoff = lds_byte(wr * 64 + fr, fq * 8), boff = lds_byte(wc * 32 + fr, fq * 8);
#define PG8_SA(b, h) (((b) * 2 + (h)) * HTB)
#define PG8_SB(b, h) ((4 + (b) * 2 + (h)) * HTB)
#define PG8_STAGE(bufoff, gbase, voff) do { _Pragma("unroll") for (int _i = 0; _i < 2; ++_i) \
        __builtin_amdgcn_global_load_lds((const unsigned*)((const char*)(gbase) + (voff)[_i]), (PG8_LAS unsigned*)(lds + (bufoff) + ldsw + _i * 8192), 16, 0, 0); } while (0)
#define PG8_LDA(dst, b, h) do { _Pragma("unroll") for (int m = 0; m < 4; ++m) _Pragma("unroll") for (int k = 0; k < 2; ++k) dst[m][k] = *(const PG8_LAS bf16x8*)(lds + PG8_SA(b, h) + aoff + m * 2048 + k * 1024); } while (0)
#define PG8_LDB(dst, b, h) do { _Pragma("unroll") for (int n = 0; n < 2; ++n) _Pragma("unroll") for (int k = 0; k < 2; ++k) dst[n][k] = *(const PG8_LAS bf16x8*)(lds + PG8_SB(b, h) + boff + n * 2048 + k * 1024); } while (0)
#define PG8_MMA(ai, bj, At, Bt) do { __builtin_amdgcn_s_setprio(1); _Pragma("unroll") for (int m = 0; m < 4; ++m) _Pragma("unroll") for (int n = 0; n < 2; ++n) _Pragma("unroll") for (int k = 0; k < 2; ++k) \
        acc[ai][bj][m][n] = __builtin_amdgcn_mfma_f32_16x16x32_bf16(Bt[n][k], At[m][k], acc[ai][bj][m][n], 0, 0, 0); __builtin_amdgcn_s_setprio(0); } while (0)
#define PG8_WAIT_V(n) asm volatile("s_waitcnt vmcnt(" #n ")" ::: "memory")
#define PG8_WAIT_L(n) asm volatile("s_waitcnt lgkmcnt(" #n ")" ::: "memory")
#define PG8_BAR __builtin_amdgcn_s_barrier()
#define PG8_SCHED __builtin_amdgcn_sched_barrier(0)
    Unit cur, nxt; int ui = 0;
    if (!S.next(0, cur)) return;
    f32x4 acc[2][2][4][2];
#pragma unroll
    for (int a = 0; a < 2; ++a)
#pragma unroll
        for (int b = 0; b < 2; ++b)
#pragma unroll
            for (int m = 0; m < 4; ++m)
#pragma unroll
                for (int n = 0; n < 2; ++n) acc[a][b][m][n] = (f32x4){0.f, 0.f, 0.f, 0.f};
    bf16x8 At[4][2], B0[2][2], B1[2][2];
    const char* cA = (const char*)g.A + (size_t)cur.pm * tstep; const char* cB = (const char*)g.Bt + (size_t)cur.pn * tstep;
    S.a_ready(cur);
    if constexpr (SP2) {
        PG8_STAGE(PG8_SB(0, 0), cB, voffB); PG8_STAGE(PG8_SB(0, 1), cB + hstep, voffB); PG8_STAGE(PG8_SA(0, 0), cA, voffA); PG8_STAGE(PG8_SA(0, 1), cA + hstep, voffA);
        if (wr == 1) PG8_BAR;
        PG8_WAIT_V(2); PG8_BAR;
        PG8_STAGE(PG8_SB(1, 0), cB + kstep, voffB); PG8_STAGE(PG8_SA(1, 0), cA + kstep, voffA); PG8_STAGE(PG8_SB(1, 1), cB + hstep + kstep, voffB);
        PG8_WAIT_V(6); PG8_BAR;
    } else {
        PG8_STAGE(PG8_SB(0, 0), cB, voffB); PG8_STAGE(PG8_SA(0, 0), cA, voffA); PG8_STAGE(PG8_SB(0, 1), cB + hstep, voffB); PG8_STAGE(PG8_SA(0, 1), cA + hstep, voffA);
        if (wr == 1) PG8_BAR;
        PG8_WAIT_V(4); PG8_BAR;
        PG8_STAGE(PG8_SB(1, 0), cB + kstep, voffB); PG8_STAGE(PG8_SA(1, 0), cA + kstep, voffA); PG8_STAGE(PG8_SB(1, 1), cB + hstep + kstep, voffB);
        PG8_WAIT_V(6); PG8_BAR;
    }
    for (;;) {
        const bool has_next = S.next(ui + 1, nxt);
        const char* nA = has_next ? (const char*)g.A + (size_t)nxt.pm * tstep : cA; const char* nB = has_next ? (const char*)g.Bt + (size_t)nxt.pn * tstep : cB;
        for (int t = 0; t < nt; t += 2) {
            const bool last = (t == nt - 2);
            const char* a1 = cA + (size_t)(t + 1) * kstep;
            const char* a2 = last ? nA : cA + (size_t)(t + 2) * kstep; const char* b2 = last ? nB : cB + (size_t)(t + 2) * kstep;
            const char* a3 = a2 + kstep; const char* b3 = b2 + kstep;
            if (last && has_next) S.a_ready(nxt);
            if constexpr (SP2) {
            PG8_LDB(B0, 0, 0); PG8_LDB(B1, 0, 1); PG8_SCHED; PG8_LDA(At, 0, 0); PG8_STAGE(PG8_SA(1, 1), a1 + hstep, voffA);
            PG8_WAIT_V(8); PG8_WAIT_L(0); PG8_BAR; PG8_MMA(0, 0, At, B0); PG8_MMA(0, 1, At, B1); PG8_BAR; PG8_SCHED;
            PG8_LDA(At, 0, 1); PG8_STAGE(PG8_SB(0, 0), b2, voffB); PG8_STAGE(PG8_SB(0, 1), b2 + hstep, voffB); PG8_STAGE(PG8_SA(0, 0), a2, voffA);
            PG8_WAIT_V(8); PG8_WAIT_L(0); PG8_BAR; PG8_MMA(1, 0, At, B0); PG8_MMA(1, 1, At, B1); PG8_BAR; PG8_SCHED;
            PG8_LDB(B0, 1, 0); PG8_LDB(B1, 1, 1); PG8_SCHED; PG8_LDA(At, 1, 0); PG8_STAGE(PG8_SA(0, 1), a2 + hstep, voffA);
            PG8_WAIT_V(8); PG8_WAIT_L(0); PG8_BAR; PG8_MMA(0, 0, At, B0); PG8_MMA(0, 1, At, B1); PG8_BAR; PG8_SCHED;
            PG8_LDA(At, 1, 1); PG8_STAGE(PG8_SB(1, 0), b3, voffB); PG8_STAGE(PG8_SB(1, 1), b3 + hstep, voffB); PG8_STAGE(PG8_SA(1, 0), a3, voffA);
            PG8_WAIT_V(8); PG8_WAIT_L(0); PG8_BAR; PG8_MMA(1, 0, At, B0); PG8_MMA(1, 1, At, B1); PG8_BAR; PG8_SCHED;
            } else {
            PG8_LDB(B0, 0, 0); PG8_SCHED; PG8_LDA(At, 0, 0); PG8_STAGE(PG8_SA(1, 1), a1 + hstep, voffA);
            PG8_WAIT_L(8); PG8_BAR; PG8_WAIT_L(0); PG8_MMA(0, 0, At, B0); PG8_BAR; PG8_SCHED;
            PG8_LDB(B1, 0, 1); PG8_STAGE(PG8_SB(0, 0), b2, voffB);
            PG8_BAR; PG8_WAIT_L(0); PG8_MMA(0, 1, At, B1); PG8_BAR;
            PG8_LDA(At, 0, 1); PG8_STAGE(PG8_SA(0, 0), a2, voffA);
            PG8_BAR; PG8_WAIT_L(0); PG8_MMA(1, 0, At, B0); PG8_BAR; PG8_SCHED;
            PG8_STAGE(PG8_SB(0, 1), b2 + hstep, voffB);
            PG8_WAIT_V(6); PG8_BAR; PG8_MMA(1, 1, At, B1); PG8_BAR;
            PG8_LDB(B0, 1, 0); PG8_SCHED; PG8_LDA(At, 1, 0); PG8_STAGE(PG8_SA(0, 1), a2 + hstep, voffA);
            PG8_WAIT_L(8); PG8_BAR; PG8_WAIT_L(0); PG8_MMA(0, 0, At, B0); PG8_BAR; PG8_SCHED;
            PG8_LDB(B1, 1, 1); PG8_STAGE(PG8_SB(1, 0), b3, voffB);
            PG8_BAR; PG8_WAIT_L(0); PG8_MMA(0, 1, At, B1); PG8_BAR;
            PG8_LDA(At, 1, 1); PG8_STAGE(PG8_SA(1, 0), a3, voffA);
            PG8_BAR; PG8_WAIT_L(0); PG8_MMA(1, 0, At, B0); PG8_BAR; PG8_SCHED;
            PG8_STAGE(PG8_SB(1, 1), b3 + hstep, voffB);
            PG8_WAIT_V(6); PG8_BAR; PG8_MMA(1, 1, At, B1); PG8_BAR;
            }
        }
        if constexpr (ALIGN_EPI) { if (wr == 0) PG8_BAR; }
        if constexpr (!Epi::AFTER_DRAIN) { E(acc, cur, wr, wc, fr, fq); S.done(cur); }
        if (!has_next) break;
#pragma unroll
        for (int a = 0; a < 2; ++a)
#pragma unroll
            for (int b = 0; b < 2; ++b)
#pragma unroll
                for (int m = 0; m < 4; ++m)
#pragma unroll
                    for (int n = 0; n < 2; ++n) acc[a][b][m][n] = (f32x4){0.f, 0.f, 0.f, 0.f};
        cur = nxt; cA = nA; cB = nB; ++ui;
        if constexpr (ALIGN_EPI) { if (wr == 1) PG8_BAR; }
    }
    PG8_WAIT_V(0);
    if constexpr (!ALIGN_EPI) { if (wr == 0) PG8_BAR; }
    PG8_BAR;
    if constexpr (Epi::AFTER_DRAIN) { E.fused(acc, cur, wr, wc, fr, fq, lds, wid, lane); S.done(cur); }
#undef PG8_SA
#undef PG8_SB
#undef PG8_STAGE
#undef PG8_LDA
#undef PG8_LDB
#undef PG8_MMA
#undef PG8_WAIT_V
#undef PG8_WAIT_L
#undef PG8_BAR
#undef PG8_SCHED
}
}
typedef unsigned short bf16;
constexpr int NB = 8, S = 4096, D = 1024, T = NB * S, GW = 256, DIN = 3912, DINP = 4096, NMEM = 256;
constexpr float LN_EPS = 1e-5f;
constexpr float ALPHA = 1.41421356237309515f;
constexpr size_t MiB = 1u << 20;
constexpr size_t WS_CTL = 0, CTL_ZERO_BYTES = 1 * MiB;
constexpr size_t WS_WIN = 2 * MiB;
constexpr size_t WS_WOUT = 18 * MiB;
constexpr size_t WS_TBL = 22 * MiB;
constexpr size_t WS_WMT = 23 * MiB;
constexpr size_t WS_KM = 25 * MiB;
constexpr size_t WS_VM = 27 * MiB;
constexpr size_t WS_HB = 32 * MiB;
constexpr size_t WS_MIX = 96 * MiB;
constexpr size_t WS_MEMB = WS_MIX;
constexpr size_t WS_P13 = 160 * MiB;
constexpr size_t WS_IQ = 368 * MiB;
constexpr size_t WS_IK = 400 * MiB;
constexpr size_t WS_IW = 404 * MiB;
constexpr size_t WS_END = 406 * MiB;
enum Grp { G_AU = 0, G_AV, G_AG, G_BQ, G_BK, G_BV, G_BG, G_CQ, G_CK, G_CV, G_CG, G_MQ, G_MG };
constexpr int CW_BAR = 4096;

__device__ __forceinline__ float bf2f(bf16 v) { return __uint_as_float((unsigned)v << 16); }
__device__ __forceinline__ bf16 f2bf(float f) { unsigned u = __float_as_uint(f); return (bf16)((u + 0x7fffu + ((u >> 16) & 1u)) >> 16); }
__device__ __forceinline__ float fast_sigmoid(float x) { return __builtin_amdgcn_rcpf(1.f + __builtin_amdgcn_exp2f(-1.4426950408889634f * x)); }
__device__ __forceinline__ float gelu_tanh(float x) { const float u = 0.7978845608028654f * (x + 0.044715f * x * x * x); return x * fast_sigmoid(2.f * u); }
__device__ __forceinline__ float silu(float x) { return x * fast_sigmoid(x); }
__device__ __forceinline__ float wave_sum(float v) {
#pragma unroll
    for (int o = 1; o < 64; o <<= 1) v += __shfl_xor(v, o);
    return v;
}
__device__ __forceinline__ float wave_max(float v) {
#pragma unroll
    for (int o = 1; o < 64; o <<= 1) v = fmaxf(v, __shfl_xor(v, o));
    return v;
}
__host__ __device__ __forceinline__ int perm_col(int col) {
    if (col < 3328) return col;
    if (col < 3392) return 3840 + (col - 3328);
    if (col < 3400) return 3904 + (col - 3392);
    if (col < 3656) return 3328 + (col - 3400);
    return 3584 + (col - 3656);
}

namespace pg8 {
__device__ __forceinline__ f32x4 act4(f32x4 v, int mode) {
    if (mode == 1) { v[0] = gelu_tanh(v[0]); v[1] = gelu_tanh(v[1]); v[2] = gelu_tanh(v[2]); v[3] = gelu_tanh(v[3]); }
    else if (mode == 2) { v[0] = silu(v[0]); v[1] = silu(v[1]); v[2] = silu(v[2]); v[3] = silu(v[3]); }
    else if (mode == 3) { v = v * 0.125f; }
    else if (mode == 4) { v = v * (0.125f * 1.4426950408889634f); }
    return v;
}
struct EpiRoute {
    static constexpr bool PERM = true, AFTER_DRAIN = false;
    bf16_t* p13; bf16_t* iq; bf16_t* ik; float* iw; const float* bias;
    __device__ __forceinline__ void operator()(const f32x4 (&acc)[2][2][4][2], const Unit& u, int wr, int wc, int fr, int fq) const {
        const int pn = u.pn, row0 = u.pm * BM + wr * 64 + fr, cl0 = wc * 32 + 8 * fq;
        f32x4 bv[2][2];
#pragma unroll
        for (int bj = 0; bj < 2; ++bj)
#pragma unroll
            for (int n = 0; n < 2; ++n) bv[bj][n] = *(const f32x4*)(bias + pn * BM + bj * HALF + cl0 + 4 * n);
        if (pn == 15) {
#pragma unroll
            for (int ai = 0; ai < 2; ++ai)
#pragma unroll
                for (int m = 0; m < 4; ++m) { const size_t row = (size_t)(row0 + ai * HALF + m * 16);
                    const f32x4 v0 = acc[ai][0][m][0] + bv[0][0], v1 = acc[ai][0][m][1] + bv[0][1];
                    if (wc < 2) { u32x4 w; w.x = cvt_pk_bf16(v0[0], v0[1]); w.y = cvt_pk_bf16(v0[2], v0[3]); w.z = cvt_pk_bf16(v1[0], v1[1]); w.w = cvt_pk_bf16(v1[2], v1[3]); *(u32x4*)(ik + row * 64 + cl0) = w; }
                    else if (wc == 2 && fq == 0) { *(f32x4*)(iw + row * 8) = v0; *(f32x4*)(iw + row * 8 + 4) = v1; } }
            return;
        }
        bf16_t* base; int ldc, mode;
        if (pn <= 10) { base = p13 + (size_t)pn * T * GW; ldc = GW; mode = (pn == G_AU || pn == G_AV) ? 1 : (pn == G_AG || pn == G_BG || pn == G_CG) ? 2 : (pn == G_BQ || pn == G_CQ) ? 4 : 0; }
        else if (pn <= 12) { base = iq + (pn - 11) * 256; ldc = 512; mode = 0; }
        else if (pn == 13) { base = p13 + (size_t)G_MQ * T * GW; ldc = GW; mode = 4; }
        else { base = p13 + (size_t)G_MG * T * GW; ldc = GW; mode = 2; }
#pragma unroll
        for (int ai = 0; ai < 2; ++ai)
#pragma unroll
            for (int m = 0; m < 4; ++m) { bf16_t* rowp = base + (size_t)(row0 + ai * HALF + m * 16) * ldc + cl0;
#pragma unroll
                for (int bj = 0; bj < 2; ++bj) { const f32x4 v0 = act4(acc[ai][bj][m][0] + bv[bj][0], mode), v1 = act4(acc[ai][bj][m][1] + bv[bj][1], mode);
                    u32x4 w; w.x = cvt_pk_bf16(v0[0], v0[1]); w.y = cvt_pk_bf16(v0[2], v0[3]); w.z = cvt_pk_bf16(v1[0], v1[1]); w.w = cvt_pk_bf16(v1[2], v1[3]);
                    *(u32x4*)(rowp + bj * HALF) = w; } }
    }
};
struct EpiResid {
    static constexpr bool PERM = false, AFTER_DRAIN = false;
    float* out; const float* bias;
    __device__ __forceinline__ void operator()(const f32x4 (&acc)[2][2][4][2], const Unit& u, int wr, int wc, int fr, int fq) const {
        const int col0 = u.pn * BM + wc * 32 + 4 * fq;
#pragma unroll
        for (int ai = 0; ai < 2; ++ai)
#pragma unroll
            for (int m = 0; m < 4; ++m) { float* rowp = out + (size_t)(u.pm * BM + ai * HALF + wr * 64 + m * 16 + fr) * D + col0;
#pragma unroll
                for (int bj = 0; bj < 2; ++bj)
#pragma unroll
                    for (int n = 0; n < 2; ++n) { float* p = rowp + bj * HALF + n * 16; const f32x4 bv = *(const f32x4*)(bias + col0 + bj * HALF + n * 16);
                        const f32x4 h = *(const f32x4*)p; *(f32x4*)p = h * ALPHA + acc[ai][bj][m][n] + bv; } }
    }
};
struct EpiKV {
    static constexpr bool PERM = true, AFTER_DRAIN = false;
    bf16_t* km; bf16_t* vm;
    __device__ __forceinline__ void operator()(const f32x4 (&acc)[2][2][4][2], const Unit& u, int wr, int wc, int fr, int fq) const {
        bf16_t* base = km + (size_t)(u.pn & 1) * ((WS_VM - WS_KM) / 2) + (size_t)(u.pn >> 1) * NB * NMEM * 256;
        const int row0 = u.pm * BM + wr * 64 + fr, cl0 = wc * 32 + 8 * fq;
#pragma unroll
        for (int ai = 0; ai < 2; ++ai)
#pragma unroll
            for (int m = 0; m < 4; ++m) { bf16_t* rowp = base + (size_t)(row0 + ai * HALF + m * 16) * 256 + cl0;
#pragma unroll
                for (int bj = 0; bj < 2; ++bj) { const f32x4 v0 = acc[ai][bj][m][0], v1 = acc[ai][bj][m][1];
                    u32x4 w; w.x = cvt_pk_bf16(v0[0], v0[1]); w.y = cvt_pk_bf16(v0[2], v0[3]); w.z = cvt_pk_bf16(v1[0], v1[1]); w.w = cvt_pk_bf16(v1[2], v1[3]);
                    *(u32x4*)(rowp + bj * HALF) = w; } }
    }
};
}
#define GAS __attribute__((address_space(1)))
#define LAS __attribute__((address_space(3)))
typedef unsigned short bf16;
typedef unsigned v4u __attribute__((ext_vector_type(4)));
typedef float f32x4 __attribute__((ext_vector_type(4)));
typedef short bf16x8 __attribute__((ext_vector_type(8)));
typedef GAS unsigned gu32;
typedef GAS unsigned long long gu64;
#define RLX_AGENT __ATOMIC_RELAXED, __HIP_MEMORY_SCOPE_AGENT
#define LDS_WAIT() asm volatile("s_waitcnt lgkmcnt(0)" ::: "memory")
#define VM_WAIT() asm volatile("s_waitcnt vmcnt(0)" ::: "memory")
__device__ __forceinline__ unsigned long long rt() { return __builtin_amdgcn_s_memrealtime(); }
__device__ __forceinline__ unsigned pk2(float lo, float hi) { return (unsigned)f2bf(lo) | ((unsigned)f2bf(hi) << 16); }

#define XB_TMO      128
#define XB_XCNT(j)  (256  + 64 * (j))
#define XB_XSUB(j)  (1280 + 64 * (j))
#define XB_XGEN(j)  (2304 + 64 * (j))
#define XB_TOP      3328
#define XB_TOPGEN   3392
#define XCD_BAR_WORDS 3456
#define XB_SPIN_CAP (1u << 18)

__device__ __forceinline__ unsigned xb_ld(unsigned* p)              { return __hip_atomic_load(p, __ATOMIC_RELAXED, __HIP_MEMORY_SCOPE_AGENT); }
__device__ __forceinline__ unsigned xb_add(unsigned* p, unsigned v) { return __hip_atomic_fetch_add(p, v, __ATOMIC_RELAXED, __HIP_MEMORY_SCOPE_AGENT); }
__device__ __forceinline__ unsigned xb_xcc_id() { return (unsigned)__builtin_amdgcn_s_getreg((3 << 11) | 20) & 0xFu; }
#define XB_SPIN(cond, bar) do { unsigned _sp = 0; while (cond) { __builtin_amdgcn_s_sleep(1); \
    if ((++_sp & 255u) == 0u) { if (xb_ld(&(bar)[XB_TMO])) break; if (_sp > XB_SPIN_CAP) { atomicAdd(&(bar)[XB_TMO], 1u); break; } } } } while (0)

struct XcdBarrier {
    unsigned* bar; unsigned x;
    volatile LAS unsigned* st;
};

__device__ __forceinline__ XcdBarrier xcd_barrier_post(unsigned* bar, volatile LAS unsigned* st) {
    XcdBarrier b; b.bar = bar; b.x = xb_xcc_id(); b.st = st;
    if (threadIdx.x == 0) (void)xb_add(&bar[XB_XCNT(b.x)], 1u);
    return b;
}
__device__ __forceinline__ void xcd_barrier_complete(unsigned* bar, unsigned x, unsigned& nloc, unsigned& nx) {
    const unsigned G = gridDim.x * gridDim.y * gridDim.z;
    unsigned sum, cnt, mine, sp = 0u;
    for (;;) {
        sum = 0u; cnt = 0u; mine = 0u;
#pragma unroll
        for (unsigned j = 0; j < 16; ++j) { const unsigned c = xb_ld(&bar[XB_XCNT(j)]); sum += c; cnt += (c > 0u) ? 1u : 0u; mine = (j == x) ? c : mine; }
        if (sum == G) break;
        __builtin_amdgcn_s_sleep(1);
        if ((++sp & 255u) == 0u) { if (xb_ld(&bar[XB_TMO])) break; if (sp > XB_SPIN_CAP) { atomicAdd(&bar[XB_TMO], 1u); break; } }
    }
    nloc = mine > 0u ? mine : 1u; nx = cnt > 0u ? cnt : 1u;
}

__device__ __forceinline__ void xcd_barrier(const XcdBarrier& b) {
    asm volatile("s_waitcnt vmcnt(0)" ::: "memory");
    __syncthreads();
    if (threadIdx.x == 0) {
        unsigned* bar = b.bar;
        __builtin_amdgcn_s_waitcnt(0);
        unsigned nloc = b.st[0], nx = b.st[1];
        if (nloc == 0u) { xcd_barrier_complete(bar, b.x, nloc, nx); b.st[0] = nloc; b.st[1] = nx; }
        const unsigned old = xb_add(&bar[XB_XSUB(b.x)], 1u);
        const unsigned gen = old / nloc;
        if (old + 1u == (gen + 1u) * nloc) {
            __builtin_amdgcn_fence(__ATOMIC_RELEASE, "agent");
            asm volatile("s_waitcnt vmcnt(0)" ::: "memory");
            const unsigned og = xb_add(&bar[XB_TOP], 1u);
            const unsigned tg = og / nx;
            if (og + 1u == (tg + 1u) * nx) xb_add(&bar[XB_TOPGEN], 1u);
            else XB_SPIN(xb_ld(&bar[XB_TOPGEN]) == tg, bar);
            __builtin_amdgcn_fence(__ATOMIC_ACQUIRE, "agent");
            xb_add(&bar[XB_XGEN(b.x)], 1u);
            asm volatile("s_waitcnt vmcnt(0)" ::: "memory");
        } else {
            XB_SPIN(xb_ld(&bar[XB_XGEN(b.x)]) == gen, bar);
            __builtin_amdgcn_fence(__ATOMIC_ACQUIRE, "agent");
            asm volatile("s_waitcnt vmcnt(0)" ::: "memory");
        }
    }
    __syncthreads();
}
namespace att {
typedef short bf16x8 __attribute__((ext_vector_type(8)));
typedef short s16x4 __attribute__((ext_vector_type(4)));
typedef float f32x16 __attribute__((ext_vector_type(16)));
typedef float f32x2_t __attribute__((ext_vector_type(2)));
typedef __bf16 bf16x2_t __attribute__((ext_vector_type(2)));
typedef unsigned u32x4 __attribute__((ext_vector_type(4)));
typedef unsigned u32x2 __attribute__((ext_vector_type(2)));
constexpr int L_K = 0, L_V = 32768, L_OST = 65536, L_BM = 98304, BM_STRIDE = 130  , L_BIAS = L_BM + 64 * BM_STRIDE * 4  , L_WS = L_BIAS + 4352  , L_END = L_WS + 8 * 256;
constexpr float LOG2E = 1.4426950408889634f;
__device__ __forceinline__ int crow(int r, int hi) { return (r & 3) + 8 * (r >> 2) + 4 * hi; }
__device__ __forceinline__ unsigned cvtpk(float lo, float hi) { f32x2_t v = {lo, hi}; bf16x2_t b = __builtin_convertvector(v, bf16x2_t); return __builtin_bit_cast(unsigned, b); }
__device__ __forceinline__ s16x4 vtr(const LAS unsigned char* p) { typedef short v4i16_t __attribute__((ext_vector_type(4))); return __builtin_bit_cast(s16x4, __builtin_amdgcn_ds_read_tr16_b64_v4i16((LAS v4i16_t*)p)); }

__device__ __forceinline__ void fill_bias(LAS unsigned char* lds, const float* tbl, int tid) {
    LAS float* bl = (LAS float*)(lds + L_BIAS);
    for (int i = tid; i < 4 * 257; i += 512) { const int h = i / 257; bl[i] = (tbl[i] - tbl[h * 257 + 256]) * LOG2E; }
}

struct Cfg { const bf16* Q; const bf16* K; const bf16* V; const bf16* Gt; bf16* mix; int colofs; };

template <int MODE>
__device__ __forceinline__ void unit(LAS unsigned char* lds, const Cfg& A, int tok0, size_t kvrow0, int ntiles, int delta0, int tid_in) {
    int tid = tid_in; asm volatile("" : "+v"(tid));
    const int lane = tid & 63, wave = __builtin_amdgcn_readfirstlane(tid >> 6), h = wave >> 1, qh = wave & 1, r32 = lane & 31, hi = lane >> 5;
    const int qloc = 32 * qh + r32;
    bf16x8 qr[4];
    { const bf16* qp = A.Q + (size_t)(tok0 + qloc) * GW + h * 64 + 8 * hi;
#pragma unroll
      for (int d0 = 0; d0 < 4; ++d0) qr[d0] = *(const bf16x8*)(qp + 16 * d0); }
    const int k0 = tid >> 5, rem = tid & 31, sh = rem >> 3, ch = rem & 7;
    const unsigned kw = L_K + sh * 8192 + ch * 1024 + ((k0 ^ ch) << 4);
    const unsigned vw = L_V + sh * 8192 + (ch >> 2) * 4096 + (k0 >> 3) * 512 + (k0 & 7) * 64 + (ch & 3) * 16;
    const bf16* kg = A.K + (kvrow0 + k0) * GW + rem * 8;
    const bf16* vg = A.V + (kvrow0 + k0) * GW + rem * 8;
    u32x4 kreg[4], vreg[4];
#pragma unroll
    for (int i = 0; i < 4; ++i) { kreg[i] = *(const u32x4*)(kg + (size_t)(16 * i) * GW); vreg[i] = *(const u32x4*)(vg + (size_t)(16 * i) * GW); }
    const LAS unsigned char* kb = lds + L_K + h * 8192 + hi * 1024;
    const LAS unsigned char* vb = lds + L_V + h * 8192 + ((lane >> 4) & 1) * 32 + (lane & 3) * 8 + (4 * hi + ((lane & 15) >> 2)) * 64;
    LAS float* wsf = (LAS float*)(lds + L_WS + wave * 256);
    const LAS float* biasL = (const LAS float*)(lds + L_BIAS) + h * 257;
    const LAS unsigned* bmrow = (const LAS unsigned*)(lds + L_BM) + qloc * BM_STRIDE;
    f32x16 o0 = {}, o1 = {};
    float mrun = -INFINITY, lsum = 0.f;
    for (int t = 0; t < ntiles; ++t) {
        __syncthreads();
#pragma unroll
        for (int i = 0; i < 4; ++i) { *(LAS u32x4*)(lds + kw + 256 * i) = kreg[i]; *(LAS u32x4*)(lds + vw + 1024 * i) = vreg[i]; }
        __syncthreads();
        if (t + 1 < ntiles) {
#pragma unroll
            for (int i = 0; i < 4; ++i) { kreg[i] = *(const u32x4*)(kg + (size_t)((t + 1) * 64 + 16 * i) * GW); vreg[i] = *(const u32x4*)(vg + (size_t)((t + 1) * 64 + 16 * i) * GW); }
        }
        f32x16 p0 = {}, p1 = {};
#pragma unroll
        for (int d0 = 0; d0 < 4; ++d0) {
            const int chunk = 2 * d0 + hi;
            const LAS unsigned char* kp = kb + d0 * 2048 + ((r32 ^ chunk) << 4);
            const bf16x8 a0 = *(const LAS bf16x8*)kp, a1 = *(const LAS bf16x8*)(kp + 512);
            p0 = __builtin_amdgcn_mfma_f32_32x32x16_bf16(a0, qr[d0], p0, 0, 0, 0);
            p1 = __builtin_amdgcn_mfma_f32_32x32x16_bf16(a1, qr[d0], p1, 0, 0, 0);
        }
        if (MODE != 2) {
            const int dl = delta0 - 64 * t;
            if (dl < 192) {
                const int base = dl + qloc + 128;
#pragma unroll
                for (int r = 0; r < 16; ++r) { const int kl = crow(r, hi); int i0 = base - kl, i1 = base - kl - 32; i0 = i0 > 256 ? 256 : i0; i1 = i1 > 256 ? 256 : i1; p0[r] += biasL[i0]; p1[r] += biasL[i1]; }
            }
        }
        float mloc = fmaxf(p0[0], p1[0]);
#pragma unroll
        for (int r = 1; r < 16; ++r) mloc = fmaxf(mloc, fmaxf(p0[r], p1[r]));
        mloc = fmaxf(mloc, __shfl_xor(mloc, 32));
        const float mnew = fmaxf(mrun, mloc);
        const bool grew = mnew > mrun;
        const float alpha = __builtin_amdgcn_exp2f(mrun - mnew);
        mrun = mnew;
#pragma unroll
        for (int r = 0; r < 16; ++r) { p0[r] = __builtin_amdgcn_exp2f(p0[r] - mnew); p1[r] = __builtin_amdgcn_exp2f(p1[r] - mnew); }
        if (MODE == 1) {
            const u32x2 w = *(const LAS u32x2*)(bmrow + 2 * t);
            const unsigned w0 = w.x >> (4 * hi), w1 = w.y >> (4 * hi);
#pragma unroll
            for (int r = 0; r < 16; ++r) { const int bit = (r & 3) + 8 * (r >> 2);
                p0[r] = __uint_as_float(__float_as_uint(p0[r]) & (unsigned)__builtin_amdgcn_sbfe((int)w0, bit, 1));
                p1[r] = __uint_as_float(__float_as_uint(p1[r]) & (unsigned)__builtin_amdgcn_sbfe((int)w1, bit, 1)); }
        }
        float ps = 0.f;
#pragma unroll
        for (int r = 0; r < 16; ++r) ps += p0[r] + p1[r];
        lsum = lsum * alpha + ps;
        if (__any(grew)) {
            if (hi == 0) wsf[r32] = alpha;
            asm volatile("s_waitcnt lgkmcnt(0)" ::: "memory");
#pragma unroll
            for (int g = 0; g < 4; ++g) { const f32x4 a = *(const LAS f32x4*)(wsf + 8 * g + 4 * hi);
#pragma unroll
                for (int j = 0; j < 4; ++j) { o0[4 * g + j] *= a[j]; o1[4 * g + j] *= a[j]; } }
        }
        u32x4 pw[4];
        pw[0] = (u32x4){cvtpk(p0[0], p0[1]), cvtpk(p0[2], p0[3]), cvtpk(p0[4], p0[5]), cvtpk(p0[6], p0[7])};
        pw[1] = (u32x4){cvtpk(p0[8], p0[9]), cvtpk(p0[10], p0[11]), cvtpk(p0[12], p0[13]), cvtpk(p0[14], p0[15])};
        pw[2] = (u32x4){cvtpk(p1[0], p1[1]), cvtpk(p1[2], p1[3]), cvtpk(p1[4], p1[5]), cvtpk(p1[6], p1[7])};
        pw[3] = (u32x4){cvtpk(p1[8], p1[9]), cvtpk(p1[10], p1[11]), cvtpk(p1[12], p1[13]), cvtpk(p1[14], p1[15])};
#pragma unroll
        for (int ks = 0; ks < 4; ++ks) {
            const bf16x8 pa = __builtin_bit_cast(bf16x8, pw[ks]);
            const s16x4 l0 = vtr(vb + ks * 1024), h0 = vtr(vb + ks * 1024 + 512), l1 = vtr(vb + 4096 + ks * 1024), h1 = vtr(vb + 4096 + ks * 1024 + 512);
            const bf16x8 v0 = (bf16x8){l0[0], l0[1], l0[2], l0[3], h0[0], h0[1], h0[2], h0[3]}, v1 = (bf16x8){l1[0], l1[1], l1[2], l1[3], h1[0], h1[1], h1[2], h1[3]};
            o0 = __builtin_amdgcn_mfma_f32_32x32x16_bf16(pa, v0, o0, 0, 0, 0);
            o1 = __builtin_amdgcn_mfma_f32_32x32x16_bf16(pa, v1, o1, 0, 0, 0);
        }
    }
    lsum += __shfl_xor(lsum, 32);
    if (hi == 0) wsf[r32] = __builtin_amdgcn_rcpf(lsum);
    asm volatile("s_waitcnt lgkmcnt(0)" ::: "memory");
    LAS bf16* stg = (LAS bf16*)(lds + L_OST + wave * 4096);
#pragma unroll
    for (int g = 0; g < 4; ++g) { const f32x4 a = *(const LAS f32x4*)(wsf + 8 * g + 4 * hi);
#pragma unroll
        for (int j = 0; j < 4; ++j) { const int q = 8 * g + 4 * hi + j; stg[q * 64 + r32] = f2bf(o0[4 * g + j] * a[j]); stg[q * 64 + 32 + r32] = f2bf(o1[4 * g + j] * a[j]); } }
    asm volatile("s_waitcnt lgkmcnt(0)" ::: "memory");
#pragma unroll
    for (int i = 0; i < 4; ++i) {
        const int row = i * 8 + (lane >> 3), c8 = lane & 7;
        const u32x4 ov = *(const LAS u32x4*)(stg + row * 64 + c8 * 8);
        const size_t tok = (size_t)(tok0 + 32 * qh + row);
        const u32x4 gv = *(const u32x4*)(A.Gt + tok * GW + h * 64 + c8 * 8);
        u32x4 res;
#pragma unroll
        for (int e = 0; e < 4; ++e) { const float a0 = __uint_as_float(ov[e] << 16) * __uint_as_float(gv[e] << 16), a1 = __uint_as_float(ov[e] & 0xffff0000u) * __uint_as_float(gv[e] & 0xffff0000u); res[e] = cvtpk(a0, a1); }
        *(u32x4*)(A.mix + tok * D + A.colofs + h * 64 + c8 * 8) = res;
    }
}
}
namespace c1 {
typedef short bf16x8 __attribute__((ext_vector_type(8)));
typedef short s16x2 __attribute__((ext_vector_type(2)));
typedef float f32x4 __attribute__((ext_vector_type(4)));
typedef _Float16 f16x2 __attribute__((ext_vector_type(2)));
constexpr int L_HIST = 0, HSTR = 257, L_TIE = 16512, L_CTL = L_TIE + 8192  ;
__device__ __forceinline__ unsigned ord16x2(float a, float b) {
    const f16x2 hv = {(_Float16)a, (_Float16)b};
    const s16x2 x = __builtin_bit_cast(s16x2, hv);
    const s16x2 m = x >> 15;
    const s16x2 y = x ^ (m | (s16x2){(short)0x8000, (short)0x8000});
    return __builtin_bit_cast(unsigned, y);
}
__device__ __forceinline__ void scan_pass(LAS unsigned char* lds, int wave, int lane, int need_word  , int w_bin, int w_need, int w_cnt) {
    const int q = 2 * wave + (lane >> 5), l32 = lane & 31, hb = 248 - 8 * l32;
    LAS unsigned* hist = (LAS unsigned*)(lds + L_HIST) + q * HSTR + hb;
    volatile LAS unsigned* ctl = (volatile LAS unsigned*)(lds + L_CTL) + q * 8;
    unsigned cnt[8]; unsigned cs = 0;
#pragma unroll
    for (int e = 0; e < 8; ++e) { cnt[e] = hist[e]; cs += cnt[e]; hist[e] = 0u; }
    unsigned P = cs;
#pragma unroll
    for (int o = 1; o < 32; o <<= 1) { const unsigned v = __shfl_up(P, o, 32); if (l32 >= o) P += v; }
    const unsigned need = need_word < 0 ? 256u : ctl[need_word];
    if (P >= need && P - cs < need) {
        unsigned rem = need - (P - cs); int bin = hb; unsigned got = 0; bool done = false;
#pragma unroll
        for (int e = 7; e >= 0; --e) { if (!done) { if (cnt[e] >= rem) { bin = hb + e; got = cnt[e]; done = true; } else rem -= cnt[e]; } }
        ctl[w_bin] = (unsigned)bin; ctl[w_need] = rem; if (w_cnt >= 0) ctl[w_cnt] = got;
    }
}

__device__ __forceinline__ void chunk(LAS unsigned char* lds, const bf16* IQ, const bf16* IK, const float* IW, int b, int c, int tid) {
    const int wave0 = __builtin_amdgcn_readfirstlane(tid >> 6);
    const int npairs0 = 2 * (c + 1), npairs = npairs0;
    LAS unsigned* bm = (LAS unsigned*)(lds + att::L_BM);
    __syncthreads();
    if (c <= 3) { for (int i = tid; i < 64 * npairs; i += 512) bm[(i / npairs) * att::BM_STRIDE + (i % npairs)] = 0xffffffffu; __syncthreads(); return; }
    for (int i = tid; i < (L_CTL + 512) / 4; i += 512) ((LAS unsigned*)(lds + L_HIST))[i] = 0u;
    __syncthreads();
    for (int sg = 0; sg < 4; ++sg) {
        int tid_ = tid, wave = wave0, npairs = npairs0; asm volatile("" : "+v"(tid_), "+s"(wave), "+s"(npairs));
        const int lane = tid_ & 63, ql = lane & 15, kg = lane >> 4;
        LAS unsigned* histq = (LAS unsigned*)(lds + L_HIST) + ql * HSTR;
        volatile LAS unsigned* ctlq = (volatile LAS unsigned*)(lds + L_CTL) + ql * 8;
        LAS unsigned short* tieq = (LAS unsigned short*)(lds + L_TIE) + ql * 256;
        const bf16* ikb = IK + ((size_t)b * S + ql) * 64 + 8 * kg;
        const size_t tokq = (size_t)b * S + c * 64 + 16 * sg + ql;
        unsigned sk[16][4];
        {
            bf16x8 qb[8][2], qc[2]; float cw[8];
            {
                float qa[16];
#pragma unroll
                for (int e = 0; e < 16; ++e) qa[e] = 0.f;
#pragma unroll 1
                for (int h = 0; h < 8; ++h) { const float w = IW[tokq * 8 + h] * 0.02209708691207961f;
                    const bf16x8 f0 = *(const bf16x8*)(IQ + tokq * 512 + h * 64 + 8 * kg), f1 = *(const bf16x8*)(IQ + tokq * 512 + h * 64 + 32 + 8 * kg);
#pragma unroll
                    for (int j = 0; j < 8; ++j) { qa[j] += w * bf2f((bf16)f0[j]); qa[8 + j] += w * bf2f((bf16)f1[j]); } }
#pragma unroll
                for (int j = 0; j < 8; ++j) { qc[0][j] = (short)f2bf(qa[j]); qc[1][j] = (short)f2bf(qa[8 + j]); }
            }
            asm volatile("" ::: "memory");
#pragma unroll
            for (int h = 0; h < 8; ++h) { cw[h] = IW[tokq * 8 + h] * 0.02209708691207961f;
#pragma unroll
                for (int ks = 0; ks < 2; ++ks) qb[h][ks] = *(const bf16x8*)(IQ + tokq * 512 + h * 64 + 32 * ks + 8 * kg); }
            bf16x8 kA[2][2], kB[2][2];
#define C1_LOADK(dst, p_) do { _Pragma("unroll") for (int tt = 0; tt < 2; ++tt) { const bf16* kp_ = ikb + (size_t)(32 * (p_) + 16 * tt) * 64; dst[tt][0] = *(const bf16x8*)kp_; dst[tt][1] = *(const bf16x8*)(kp_ + 32); } } while (0)
#define C1_SLOT(i, cur, nxt) do { __builtin_amdgcn_sched_barrier(0); const int p = wave + 8 * (i); \
                if (p < npairs) { \
                    if (p + 8 < npairs && (i) < 15) C1_LOADK(nxt, p + 8); \
                    asm volatile("" ::: "memory"); \
                    _Pragma("unroll") for (int tt = 0; tt < 2; ++tt) { \
                        f32x4 acc = __builtin_amdgcn_mfma_f32_16x16x32_bf16(cur[tt][0], qc[0], (f32x4){0.f, 0.f, 0.f, 0.f}, 0, 0, 0); \
                        acc = __builtin_amdgcn_mfma_f32_16x16x32_bf16(cur[tt][1], qc[1], acc, 0, 0, 0); \
                        _Pragma("unroll") for (int h = 0; h < 8; ++h) { \
                            f32x4 x = __builtin_amdgcn_mfma_f32_16x16x32_bf16(cur[tt][0], qb[h][0], (f32x4){0.f, 0.f, 0.f, 0.f}, 0, 0, 0); \
                            x = __builtin_amdgcn_mfma_f32_16x16x32_bf16(cur[tt][1], qb[h][1], x, 0, 0, 0); \
                            _Pragma("unroll") for (int r = 0; r < 4; ++r) acc[r] = __builtin_fmaf(cw[h], __builtin_fabsf(x[r]), acc[r]); } \
                        sk[i][2 * tt] = ord16x2(acc[0], acc[1]); sk[i][2 * tt + 1] = ord16x2(acc[2], acc[3]); } \
                    _Pragma("unroll") for (int j = 0; j < 4; ++j) { __hip_atomic_fetch_add(histq + (sk[i][j] >> 24), 1u, __ATOMIC_RELAXED, __HIP_MEMORY_SCOPE_WORKGROUP); \
                                                  __hip_atomic_fetch_add(histq + ((sk[i][j] >> 8) & 255u), 1u, __ATOMIC_RELAXED, __HIP_MEMORY_SCOPE_WORKGROUP); } \
                    asm volatile("" ::: "memory"); \
                } else { sk[i][0] = 0u; sk[i][1] = 0u; sk[i][2] = 0u; sk[i][3] = 0u; } } while (0)
            if (wave < npairs) C1_LOADK(kA, wave);
            C1_SLOT(0, kA, kB); C1_SLOT(1, kB, kA); C1_SLOT(2, kA, kB); C1_SLOT(3, kB, kA); C1_SLOT(4, kA, kB); C1_SLOT(5, kB, kA); C1_SLOT(6, kA, kB); C1_SLOT(7, kB, kA);
            C1_SLOT(8, kA, kB); C1_SLOT(9, kB, kA); C1_SLOT(10, kA, kB); C1_SLOT(11, kB, kA); C1_SLOT(12, kA, kB); C1_SLOT(13, kB, kA); C1_SLOT(14, kA, kB); C1_SLOT(15, kB, kA);
#undef C1_SLOT
#undef C1_LOADK
        }
        __syncthreads();
        scan_pass(lds, wave, lane, -1, 0, 1, -1);
        __syncthreads();
        {
            const unsigned b1 = ctlq[0];
#pragma unroll
            for (int i = 0; i < 16; ++i) { __builtin_amdgcn_sched_barrier(0); if (wave + 8 * i < npairs) {
#pragma unroll
                for (int j = 0; j < 4; ++j) { const unsigned v = sk[i][j];
                    if ((v >> 24) == b1) __hip_atomic_fetch_add(histq + ((v >> 16) & 255u), 1u, __ATOMIC_RELAXED, __HIP_MEMORY_SCOPE_WORKGROUP);
                    if (((v >> 8) & 255u) == b1) __hip_atomic_fetch_add(histq + (v & 255u), 1u, __ATOMIC_RELAXED, __HIP_MEMORY_SCOPE_WORKGROUP); } } }
        }
        __syncthreads();
        scan_pass(lds, wave, lane, 1, 2, 3, 5);
        if (tid < 16) ((volatile LAS unsigned*)(lds + L_CTL))[tid * 8 + 4] = 0u;
        __syncthreads();
        const unsigned T16 = (ctlq[0] << 8) | ctlq[2], need2 = ctlq[3];
        {
#pragma unroll
            for (int i = 0; i < 16; ++i) { __builtin_amdgcn_sched_barrier(0); const int p = wave + 8 * i; if (p < npairs) {
#pragma unroll
                for (int j = 0; j < 4; ++j) { const unsigned v = sk[i][j]; const int idx0 = 32 * p + 16 * (j >> 1) + 4 * kg + 2 * (j & 1);
                    if ((v & 0xffffu) == T16) { const unsigned s = __hip_atomic_fetch_add((LAS unsigned*)(ctlq + 4), 1u, __ATOMIC_RELAXED, __HIP_MEMORY_SCOPE_WORKGROUP); if (s < 256u) tieq[s] = (unsigned short)idx0; }
                    if ((v >> 16) == T16) { const unsigned s = __hip_atomic_fetch_add((LAS unsigned*)(ctlq + 4), 1u, __ATOMIC_RELAXED, __HIP_MEMORY_SCOPE_WORKGROUP); if (s < 256u) tieq[s] = (unsigned short)(idx0 + 1); } } } }
        }
        __syncthreads();
        {
            unsigned ntie = ctlq[4]; ntie = ntie > 256u ? 256u : ntie;
            const bool all_ties = ctlq[5] <= need2;
#pragma unroll
            for (int i = 0; i < 16; ++i) { __builtin_amdgcn_sched_barrier(0); const int p = wave + 8 * i; if (p < npairs) {
                unsigned word = 0u;
#pragma unroll
                for (int j = 0; j < 4; ++j) { const unsigned v = sk[i][j];
#pragma unroll
                    for (int hf = 0; hf < 2; ++hf) { const unsigned k16 = hf ? (v >> 16) : (v & 0xffffu); const int bit = 16 * (j >> 1) + 4 * kg + 2 * (j & 1) + hf;
                        bool sel = k16 > T16;
                        if (k16 == T16) { if (all_ties) sel = true; else { const unsigned idx = 32 * p + bit; unsigned rank = 0; for (unsigned e = 0; e < ntie; ++e) rank += (tieq[e] < idx) ? 1u : 0u; sel = rank < need2; } }
                        word |= sel ? (1u << bit) : 0u; } }
                word |= __shfl_xor(word, 16); word |= __shfl_xor(word, 32);
                if (kg == 0) bm[(16 * sg + ql) * att::BM_STRIDE + p] = word; } }
        }
        __syncthreads();
    }
}
}
namespace mixa {
typedef short bf16x8 __attribute__((ext_vector_type(8)));
typedef short s16x4 __attribute__((ext_vector_type(4)));
typedef float f32x16 __attribute__((ext_vector_type(16)));
constexpr int L_VN = 0, L_OST = 65536;
__device__ __forceinline__ void unit(LAS unsigned char* lds, int blk, const bf16* au, const bf16* av, const bf16* ag, const float* lng, const float* lnb, const float* W, const float* bs, bf16* mix, int tid_in) {
    int tid = tid_in; asm volatile("" : "+v"(tid));
    const int lane = tid & 63, wave = __builtin_amdgcn_readfirstlane(tid >> 6), r32 = lane & 31, hi = lane >> 5;
    const size_t row0 = (size_t)blk * 128;
    __syncthreads();
    {
        const f32x4 gg = *(const f32x4*)(lng + lane * 4), bb = *(const f32x4*)(lnb + lane * 4);
        const unsigned wofs = L_VN + (lane >> 4) * 16384 + ((lane >> 3) & 1) * 8192 + (lane & 7) * 8;
        unsigned long long raw[16];
#pragma unroll
        for (int rr = 0; rr < 16; ++rr) raw[rr] = *(const unsigned long long*)(av + (row0 + wave * 16 + rr) * GW + lane * 4);
#pragma unroll
        for (int rr = 0; rr < 16; ++rr) { const int row = wave * 16 + rr;
            f32x4 v; v[0] = __uint_as_float((unsigned)raw[rr] << 16); v[1] = __uint_as_float((unsigned)raw[rr] & 0xffff0000u); v[2] = __uint_as_float((unsigned)(raw[rr] >> 32) << 16); v[3] = __uint_as_float((unsigned)(raw[rr] >> 32) & 0xffff0000u);
            const float mean = wave_sum((v[0] + v[1]) + (v[2] + v[3])) * (1.f / GW);
            v = v - mean;
            const float rstd = rsqrtf(wave_sum((v[0] * v[0] + v[1] * v[1]) + (v[2] * v[2] + v[3] * v[3])) * (1.f / GW) + LN_EPS);
            v = v * rstd * gg + bb;
            *(LAS unsigned long long*)(lds + wofs + row * 64) = (unsigned long long)att::cvtpk(v[0], v[1]) | ((unsigned long long)att::cvtpk(v[2], v[3]) << 32); }
    }
    __syncthreads();
    const int g = wave >> 1;
    const LAS unsigned char* vb = lds + L_VN + g * 16384 + ((lane >> 4) & 1) * 32 + (lane & 3) * 8 + (8 * hi + ((lane & 15) >> 2)) * 64;
    LAS bf16* stg = (LAS bf16*)(lds + L_OST + wave * 4096);
#pragma unroll 1
    for (int tt = 0; tt < 2; ++tt) {
        const int ib = (wave & 1) ? (tt ? 2 : 1) : (tt ? 3 : 0);
        const float* wrow = W + ((size_t)g * 128 + 32 * ib + r32) * 128 + 8 * hi;
        f32x4 wf[8][2];
#pragma unroll
        for (int ks = 0; ks < 8; ++ks) if (ks < 4 || ib >= 2) { wf[ks][0] = *(const f32x4*)(wrow + 16 * ks); wf[ks][1] = *(const f32x4*)(wrow + 16 * ks + 4); }
        f32x16 o0 = {}, o1 = {};
#pragma unroll
        for (int ks = 0; ks < 8; ++ks) if (ks < 4 || ib >= 2) {
            const att::u32x4 aw = {att::cvtpk(wf[ks][0][0], wf[ks][0][1]), att::cvtpk(wf[ks][0][2], wf[ks][0][3]), att::cvtpk(wf[ks][1][0], wf[ks][1][1]), att::cvtpk(wf[ks][1][2], wf[ks][1][3])};
            const bf16x8 a = __builtin_bit_cast(bf16x8, aw);
            const LAS unsigned char* p = vb + ks * 1024;
            const s16x4 l0 = att::vtr(p), h0 = att::vtr(p + 256), l1 = att::vtr(p + 8192), h1 = att::vtr(p + 8192 + 256);
            const bf16x8 v0 = (bf16x8){l0[0], l0[1], l0[2], l0[3], h0[0], h0[1], h0[2], h0[3]}, v1 = (bf16x8){l1[0], l1[1], l1[2], l1[3], h1[0], h1[1], h1[2], h1[3]};
            o0 = __builtin_amdgcn_mfma_f32_32x32x16_bf16(a, v0, o0, 0, 0, 0);
            o1 = __builtin_amdgcn_mfma_f32_32x32x16_bf16(a, v1, o1, 0, 0, 0);
        }
#pragma unroll
        for (int gq = 0; gq < 4; ++gq) { const f32x4 bsv = *(const f32x4*)(bs + g * 128 + 32 * ib + 8 * gq + 4 * hi);
#pragma unroll
            for (int j = 0; j < 4; ++j) { const int q = 8 * gq + 4 * hi + j; stg[q * 64 + r32] = f2bf(o0[4 * gq + j] + bsv[j]); stg[q * 64 + 32 + r32] = f2bf(o1[4 * gq + j] + bsv[j]); } }
        asm volatile("s_waitcnt lgkmcnt(0)" ::: "memory");
#pragma unroll
        for (int i = 0; i < 4; ++i) {
            const int row = i * 8 + (lane >> 3), c8 = lane & 7;
            const att::u32x4 ov = *(const LAS att::u32x4*)(stg + row * 64 + c8 * 8);
            const size_t tok = row0 + 32 * ib + row;
            const att::u32x4 uv = *(const att::u32x4*)(au + tok * GW + g * 64 + c8 * 8), gv = *(const att::u32x4*)(ag + tok * GW + g * 64 + c8 * 8);
            att::u32x4 res;
#pragma unroll
            for (int e = 0; e < 4; ++e) { const float a0 = __uint_as_float(ov[e] << 16) * __uint_as_float(uv[e] << 16) * __uint_as_float(gv[e] << 16), a1 = __uint_as_float(ov[e] & 0xffff0000u) * __uint_as_float(uv[e] & 0xffff0000u) * __uint_as_float(gv[e] & 0xffff0000u); res[e] = att::cvtpk(a0, a1); }
            *(att::u32x4*)(mix + tok * D + g * 64 + c8 * 8) = res;
        }
        asm volatile("s_waitcnt lgkmcnt(0)" ::: "memory");
    }
}
}
constexpr int RING_OFF = 0, RING_BYTES = 131072;
constexpr int LDSCTL_OFF = 147456 - 1024, MISC_OFF = LDSCTL_OFF + 320;
constexpr int SCR_OFF = 138240;
constexpr int LDS_BYTES = 147456;
constexpr int NWAVES = 8;

struct Args { const float* in[17]; float* out; unsigned char* ws; };

__device__ __forceinline__ void transpose_item(const float* W, int N, bf16* WT, bool perm, LAS float* scr, int item, int lane) {
    const int nblk = (N + 31) / 32, kb = item / nblk, nb = item % nblk, k0 = 64 * kb, n0 = 32 * nb;
    const bool nok = n0 + (lane & 31) < N;
#pragma unroll 8
    for (int i = 0; i < 32; ++i) { const int kk = 2 * i + (lane >> 5); scr[kk * 33 + (lane & 31)] = nok ? W[(size_t)(k0 + kk) * N + n0 + (lane & 31)] : 0.f; }
    asm volatile("s_waitcnt lgkmcnt(0)" ::: "memory");
    const int c = lane & 7;
#pragma unroll
    for (int j = 0; j < 4; ++j) { const int n = (lane >> 3) + 8 * j; const LAS float* s = scr + (8 * c) * 33 + n;
        if (n0 + n < N) {
            v4u o; o.x = pk2(s[0 * 33], s[1 * 33]); o.y = pk2(s[2 * 33], s[3 * 33]); o.z = pk2(s[4 * 33], s[5 * 33]); o.w = pk2(s[6 * 33], s[7 * 33]);
            const int drow = perm ? perm_col(n0 + n) : (n0 + n);
            *(GAS v4u*)(WT + (size_t)drow * 1024 + k0 + 8 * c) = o; } }
    asm volatile("s_waitcnt lgkmcnt(0)" ::: "memory");
}
__device__ __forceinline__ void ln_row(const float* in, float* out, bf16* outb, const float* g, const float* b, int lane) {
    const f32x4* xr = (const f32x4*)in + lane;
    f32x4 v[4]; float s = 0.f;
#pragma unroll
    for (int j = 0; j < 4; ++j) { v[j] = xr[64 * j]; s += (v[j].x + v[j].y) + (v[j].z + v[j].w); }
    const float mean = wave_sum(s) * (1.f / D); float s2 = 0.f;
#pragma unroll
    for (int j = 0; j < 4; ++j) { v[j] = v[j] - mean; s2 += (v[j].x * v[j].x + v[j].y * v[j].y) + (v[j].z * v[j].z + v[j].w * v[j].w); }
    const float rstd = rsqrtf(wave_sum(s2) * (1.f / D) + LN_EPS);
#pragma unroll
    for (int j = 0; j < 4; ++j) {
        const int c = 4 * (lane + 64 * j);
        const f32x4 o = v[j] * rstd * *(const f32x4*)(g + c) + *(const f32x4*)(b + c);
        *(f32x4*)(out + c) = o;
        *(unsigned long long*)(outb + c) = (unsigned long long)pk2(o.x, o.y) | ((unsigned long long)pk2(o.z, o.w) << 32);
    }
}
__device__ __forceinline__ void memkv_tile(const float* A, const float* W, bf16* km, bf16* vm, int tm, int tn, LAS float* As, LAS float* Bs, int tid) {
    const int tx = tid & 15, ty = tid >> 4, m0 = tm * 128, n0 = tn * 64;
    float acc[4][4];
#pragma unroll
    for (int i = 0; i < 4; ++i)
#pragma unroll
        for (int j = 0; j < 4; ++j) acc[i][j] = 0.f;
    for (int k0 = 0; k0 < D; k0 += 16) {
#pragma unroll
        for (int i = 0; i < 4; ++i) { const int e = tid + 512 * i, r = e >> 4, kk = e & 15; As[kk * 129 + r] = A[(size_t)(m0 + r) * D + k0 + kk]; }
#pragma unroll
        for (int i = 0; i < 2; ++i) { const int e = tid + 512 * i, kk = e >> 6, c = e & 63; Bs[kk * 65 + c] = W[(size_t)(k0 + kk) * 512 + n0 + c]; }
        __syncthreads();
#pragma unroll
        for (int kk = 0; kk < 16; ++kk) {
            float a[4], b[4];
#pragma unroll
            for (int i = 0; i < 4; ++i) { a[i] = As[kk * 129 + ty * 4 + i]; b[i] = Bs[kk * 65 + tx * 4 + i]; }
#pragma unroll
            for (int i = 0; i < 4; ++i)
#pragma unroll
                for (int j = 0; j < 4; ++j) acc[i][j] += a[i] * b[j];
        }
        __syncthreads();
    }
#pragma unroll
    for (int i = 0; i < 4; ++i)
#pragma unroll
        for (int j = 0; j < 4; ++j) { const int row = m0 + ty * 4 + i, col = n0 + tx * 4 + j;
            if (col < 256) km[(size_t)row * 256 + col] = f2bf(acc[i][j]); else vm[(size_t)row * 256 + col - 256] = f2bf(acc[i][j]); }
}

__device__ __forceinline__ void mixer_a_unit(int blk, const bf16* au, const bf16* av, const bf16* ag, const float* lng, const float* lnb, const float* ws_, const float* bs, bf16* mix, LAS float* vt, int tid) {
    const int wave = tid >> 6, lane = tid & 63;
    const size_t row0 = (size_t)blk * 128;
    for (int r = wave; r < 128; r += NWAVES) {
        const bf16* p = av + (row0 + r) * GW + lane * 4;
        float v[4]; float s = 0.f;
#pragma unroll
        for (int j = 0; j < 4; ++j) { v[j] = bf2f(p[j]); s += v[j]; }
        const float mean = wave_sum(s) * (1.f / GW); float s2 = 0.f;
#pragma unroll
        for (int j = 0; j < 4; ++j) { v[j] -= mean; s2 += v[j] * v[j]; }
        const float rstd = rsqrtf(wave_sum(s2) * (1.f / GW) + LN_EPS);
#pragma unroll
        for (int j = 0; j < 4; ++j) vt[r * 256 + lane * 4 + j] = bf2f(f2bf(v[j] * rstd * lng[lane * 4 + j] + lnb[lane * 4 + j]));
    }
    __syncthreads();
    const int ch = tid & 255, g = ch >> 6;
    for (int i = tid >> 8; i < 128; i += 2) {
        const float* wr = ws_ + ((size_t)g * 128 + i) * 128;
        const int jmax = i < 64 ? 64 : 128;
        float acc = 0.f;
        for (int j = 0; j < jmax; ++j) acc += wr[j] * vt[j * 256 + ch];
        acc += bs[g * 128 + i];
        const size_t idx = (row0 + i) * GW + ch;
        mix[(row0 + i) * D + ch] = f2bf(bf2f(au[idx]) * acc * bf2f(ag[idx]));
    }
    __syncthreads();
}
template <int MODE>
__device__ __forceinline__ void attn_wave(int token, int h, const bf16* Q, const bf16* K, const bf16* V, const bf16* G, bf16* mix, int colofs, const float* tbl,
                                          LAS float* sc, LAS float* qs, const LAS unsigned* keys, unsigned Tv, int Ti, int lane, float qscale = 1.f, const unsigned* bmg = nullptr) {
    const int b = token / S, pos = token % S, c = pos >> 6;
    int k0, k1; size_t kbase;
    if (MODE == 0) { k0 = (c >= 8 ? c - 8 : 0) * 64; k1 = (c + 1) * 64; kbase = (size_t)b * S; }
    else if (MODE == 1 || MODE == 3) { k0 = 0; k1 = (c + 1) * 64; kbase = (size_t)b * S; }
    else { k0 = 0; k1 = NMEM; kbase = (size_t)b * NMEM; }
    qs[lane] = bf2f(Q[(size_t)token * GW + h * 64 + lane]);
    asm volatile("s_waitcnt lgkmcnt(0)" ::: "memory");
    float mx = -INFINITY;
    for (int key = k0 + lane; key < k1; key += 64) {
        const bf16* kr = K + (kbase + key) * GW + h * 64;
        float s = 0.f;
#pragma unroll 8
        for (int d = 0; d < 64; ++d) s += qs[d] * bf2f(kr[d]);
        s *= qscale;
        if (MODE != 2) { int dd = pos - key; dd = dd < -128 ? -128 : (dd > 128 ? 128 : dd); s += tbl[h * 257 + dd + 128]; }
        if (MODE == 1) { const unsigned kv = keys[key]; if (!(kv > Tv || (kv == Tv && key <= Ti))) s = -INFINITY; }
        if (MODE == 3) { if (!((bmg[(size_t)token * 128 + (key >> 5)] >> (key & 31)) & 1u)) s = -INFINITY; }
        sc[key - k0] = s; mx = fmaxf(mx, s);
    }
    mx = wave_max(mx);
    float sum = 0.f;
    for (int key = k0 + lane; key < k1; key += 64) { const float p = __expf(sc[key - k0] - mx); sc[key - k0] = p; sum += p; }
    sum = wave_sum(sum);
    asm volatile("s_waitcnt lgkmcnt(0)" ::: "memory");
    float o = 0.f;
    for (int key = k0; key < k1; ++key) { const float p = sc[key - k0]; if (p != 0.f) o += p * bf2f(V[(kbase + key) * GW + h * 64 + lane]); }
    o /= sum;
    mix[(size_t)token * D + colofs + h * 64 + lane] = f2bf(o * bf2f(G[(size_t)token * GW + h * 64 + lane]));
    asm volatile("s_waitcnt lgkmcnt(0)" ::: "memory");
}
__device__ __forceinline__ int block_sum_i(int v, volatile LAS int* red, int tid) {
#pragma unroll
    for (int o = 1; o < 64; o <<= 1) v += __shfl_xor(v, o);
    __syncthreads();
    if ((tid & 63) == 0) red[tid >> 6] = v;
    __syncthreads();
    int s = 0;
#pragma unroll
    for (int w = 0; w < NWAVES; ++w) s += red[w];
    return s;
}
__device__ __forceinline__ void mixer_c_token(int token, const bf16* IQ, const bf16* IK, const float* IW, const bf16* Q, const bf16* K, const bf16* V, const bf16* G, bf16* mix, const float* tbl,
                                              LAS unsigned char* lds, int tid, float qscale = 1.f, const unsigned* bmg = nullptr, float* dacc = nullptr) {
    LAS unsigned* keys = (LAS unsigned*)(lds + RING_OFF);
    LAS float* qh = (LAS float*)(lds + SCR_OFF + 4096);
    LAS float* wq = (LAS float*)(lds + SCR_OFF + 4096 + 2048);
    volatile LAS int* red = (volatile LAS int*)(lds + SCR_OFF + 4096 + 2048 + 64);
    const int wave = tid >> 6, lane = tid & 63;
    const int b = token / S, pos = token % S, c = pos >> 6, n = (c + 1) * 64;
    qh[tid] = bf2f(IQ[(size_t)token * 512 + tid]);
    if (tid < 8) wq[tid] = IW[(size_t)token * 8 + tid] * 0.35355339059327373f;
    __syncthreads();
    for (int key = tid; key < n; key += 512) {
        const bf16* kr = IK + ((size_t)b * S + key) * 64;
        float score = 0.f;
        for (int h = 0; h < 8; ++h) {
            float s = 0.f;
#pragma unroll 8
            for (int d = 0; d < 64; ++d) s += qh[h * 64 + d] * bf2f(kr[d]);
            s *= 0.125f;
            score += fmaxf(s, 0.f) * wq[h];
        }
        const unsigned u = __float_as_uint(score);
        keys[key] = (u & 0x80000000u) ? ~u : (u | 0x80000000u);
    }
    __syncthreads();
    unsigned Tv = 0u; int Ti = 4095;
    if (n > 256) {
        unsigned prefix = 0u;
        for (int bit = 31; bit >= 0; --bit) {
            const unsigned cand = prefix | (1u << bit);
            int cnt = 0;
            for (int key = tid; key < n; key += 512) cnt += (keys[key] >= cand) ? 1 : 0;
            cnt = block_sum_i(cnt, red, tid);
            if (cnt >= 256) prefix = cand;
        }
        Tv = prefix;
        int cgt = 0;
        for (int key = tid; key < n; key += 512) cgt += (keys[key] > Tv) ? 1 : 0;
        cgt = block_sum_i(cgt, red, tid);
        const int r = 256 - cgt;
        int I = 0;
        for (int bit = 11; bit >= 0; --bit) {
            const int cand = I | (1 << bit);
            int cnt = 0;
            for (int key = tid; key < n; key += 512) cnt += (keys[key] == Tv && key < cand) ? 1 : 0;
            cnt = block_sum_i(cnt, red, tid);
            if (cnt < r) I = cand;
        }
        Ti = I;
    }
    if (bmg) {
        if (tid < 128) { unsigned w = 0u; const int lo = tid * 32;
            if (lo < n) { if (n <= 256) w = 0xffffffffu; else for (int j = 0; j < 32; ++j) { const unsigned kv = keys[lo + j]; if (kv > Tv || (kv == Tv && lo + j <= Ti)) w |= 1u << j; } }
            const unsigned o = lo < n ? bmg[(size_t)token * 128 + tid] : 0u;
            float dx = (float)__popc(w ^ o), dr = (float)__popc(w); dx = wave_sum(dx); dr = wave_sum(dr);
            if (lane == 0) { atomicAdd(dacc + 8, dx); atomicAdd(dacc + 9, dr); } }
        if (wave < 4) attn_wave<3>(token, wave, Q, K, V, G, mix, 512, tbl, (LAS float*)(lds + RING_OFF + 16384 + wave * 16384), (LAS float*)(lds + SCR_OFF + wave * 256), keys, Tv, Ti, lane, qscale, bmg);
    } else if (wave < 4) attn_wave<1>(token, wave, Q, K, V, G, mix, 512, tbl, (LAS float*)(lds + RING_OFF + 16384 + wave * 16384), (LAS float*)(lds + SCR_OFF + wave * 256), keys, Tv, Ti, lane, qscale);
    __syncthreads();
}

#ifndef REP_A
#define REP_A 1
#endif
#ifndef REP_C1
#define REP_C1 1
#endif
#ifndef REP_C2
#define REP_C2 1
#endif
#ifndef REP_B
#define REP_B 1
#endif
#ifndef REP_M
#define REP_M 1
#endif
#ifndef REP_C
#define REP_C 1
#endif
template <int OFF> __device__ __forceinline__ unsigned long long karg_u64() {
    const __attribute__((address_space(4))) char* k = (const __attribute__((address_space(4))) char*)__builtin_amdgcn_kernarg_segment_ptr();
    unsigned long long v;
    asm volatile("s_load_dwordx2 %0, %1, %2\n\ts_waitcnt lgkmcnt(0)" : "=s"(v) : "s"(k), "i"(OFF) : "memory");
    return v;
}
#define IN_PTR(i) ((const float*)karg_u64<8 * (i)>())
#define OUT_PTR() ((float*)karg_u64<8 * 17>())
#define WS_PTR() ((unsigned char*)karg_u64<8 * 18>())
#define GRP(g) ((bf16*)(WS_PTR() + WS_P13) + (size_t)(g) * T * GW)
#define GRID_BAR() do { XcdBarrier b_; b_.bar = (unsigned*)((gu32*)(WS_PTR() + WS_CTL) + CW_BAR); b_.x = xb_xcc_id(); b_.st = (volatile LAS unsigned*)((LAS unsigned char*)lds_raw + MISC_OFF) + 8; xcd_barrier(b_); } while (0)

__global__ void __launch_bounds__(NWAVES * 64, 2) mk_fwd(Args args) {
    extern __shared__ __attribute__((aligned(16))) unsigned char lds_raw[];
    {
        LAS unsigned char* lds = (LAS unsigned char*)lds_raw;
        for (int u = threadIdx.x; u < (LDS_BYTES - LDSCTL_OFF) / 4; u += NWAVES * 64) ((LAS unsigned*)(lds + LDSCTL_OFF))[u] = 0u;
        __syncthreads();
        (void)xcd_barrier_post((unsigned*)((gu32*)(WS_PTR() + WS_CTL) + CW_BAR), (volatile LAS unsigned*)(lds + MISC_OFF) + 8);
    }
    {
        LAS unsigned char* lds = (LAS unsigned char*)lds_raw;
        const int tid = threadIdx.x, lane = tid & 63, wave = __builtin_amdgcn_readfirstlane(tid >> 6);
        const int G = gridDim.x, bx = blockIdx.x, vcu = (G % 8 == 0) ? (bx % 8) * (G / 8) + bx / 8 : bx;
        const int gw = vcu * NWAVES + wave, NGW = G * NWAVES;
        unsigned char* ws = WS_PTR();
        const float* w_in = IN_PTR(4); const float* w_out = IN_PTR(13);
        bf16* WIN = (bf16*)(ws + WS_WIN); bf16* WOUT = (bf16*)(ws + WS_WOUT);
        float* tbl = (float*)(ws + WS_TBL); float* bperm = (float*)(ws + WS_TBL + 65536);
        LAS float* scr = (LAS float*)(lds + RING_OFF + wave * 16384);
        constexpr int I_IN = 16 * 123, I_OUT = 16 * 32;
        for (int it = gw; it < 2 * I_IN + 2 * I_OUT; it += NGW) {
            int r = it;
            if (r < 2 * I_IN) { const int l = r / I_IN; transpose_item(w_in + (size_t)l * D * DIN, DIN, WIN + (size_t)l * DINP * D, true, scr, r % I_IN, lane); }
            else { r -= 2 * I_IN; const int l = r / I_OUT; transpose_item(w_out + (size_t)l * D * D, D, WOUT + (size_t)l * D * D, false, scr, r % I_OUT, lane); }
        }
        { const float* b_in = IN_PTR(5);
          for (int i = bx * 512 + tid; i < 2 * DINP; i += G * 512) { const int l = i / DINP, p = i % DINP; int col = -1;
              if (p < 3328) col = p; else if (p < 3584) col = 3400 + (p - 3328); else if (p < 3840) col = 3656 + (p - 3584); else if (p < 3904) col = 3328 + (p - 3840); else if (p < 3912) col = 3392 + (p - 3904);
              bperm[i] = col >= 0 ? b_in[l * DIN + col] : 0.f; } }
        { const float* t5 = IN_PTR(11);
          for (int i = bx * 512 + tid; i < 4 * 257; i += G * 512) {
            const int h = i / 257, d = i % 257 - 128, rel = -d, n = rel < 0 ? -rel : rel;
            int bucket = rel > 0 ? 16 : 0;
            if (n < 8) bucket += n; else { int large = 8 + (31 - __clz(n * n)) - 6; if (large > 15) large = 15; bucket += large; }
            tbl[i] = t5[bucket * 4 + h];
          } }
        { const float* x = IN_PTR(0); float* out = OUT_PTR(); bf16* HB = (bf16*)(ws + WS_HB); const float* g = IN_PTR(2); const float* b = IN_PTR(3);
          for (int m = gw; m < T; m += NGW) ln_row(x + (size_t)m * D, out + (size_t)m * D, HB + (size_t)m * D, g, b, lane); }
        {
            const float* mem = IN_PTR(1); const float* w_mem = IN_PTR(12);
            bf16* MEMB = (bf16*)(ws + WS_MEMB); bf16* WMT = (bf16*)(ws + WS_WMT);
            for (int i = bx * 512 + tid; i < NB * NMEM * D / 8; i += G * 512) { const f32x4 a = *(const f32x4*)(mem + (size_t)i * 8), b2 = *(const f32x4*)(mem + (size_t)i * 8 + 4);
                v4u o; o.x = pk2(a.x, a.y); o.y = pk2(a.z, a.w); o.z = pk2(b2.x, b2.y); o.w = pk2(b2.z, b2.w); *(v4u*)(MEMB + (size_t)i * 8) = o; }
            constexpr int I_M = 16 * 16;
            for (int it = gw; it < 2 * I_M; it += NGW) { const int l = it / I_M; transpose_item(w_mem + (size_t)l * D * 512, 512, WMT + (size_t)l * 512 * D, false, scr, it % I_M, lane); }
        }
    }
    GRID_BAR();
    {
        unsigned char* ws = WS_PTR();
        pg8::Gemm g{(const bf16*)(ws + WS_MEMB), (const bf16*)(ws + WS_WMT), NB * NMEM, 1024, D}; pg8::StaticOrder SO; SO.init(NB * NMEM, 1024, gridDim.x, blockIdx.x);
        pg8::EpiKV E{(bf16*)(ws + WS_KM), (bf16*)(ws + WS_VM)};
        pg8::gemm_phase<pg8::EpiKV, pg8::StaticOrder, true, true>((LAS unsigned char*)lds_raw + RING_OFF, g, SO, E);
    }

    for (int l = 0; l < 2; ++l) {
#ifndef NO_P1
        {
            unsigned char* ws = WS_PTR();
            pg8::Gemm g{(const bf16*)(ws + WS_HB), (const bf16*)(ws + WS_WIN) + (size_t)l * DINP * D, T, DINP, D}; pg8::StaticOrder SO; SO.init(T, DINP, gridDim.x, blockIdx.x);
            pg8::EpiRoute E{(bf16*)(ws + WS_P13), (bf16*)(ws + WS_IQ), (bf16*)(ws + WS_IK), (float*)(ws + WS_IW), (const float*)(ws + WS_TBL + 65536) + l * DINP};
            pg8::gemm_phase<pg8::EpiRoute, pg8::StaticOrder, true, true>((LAS unsigned char*)lds_raw + RING_OFF, g, SO, E);
        }
#endif
        GRID_BAR();
#ifndef NO_P2
        {
            LAS unsigned char* lds = (LAS unsigned char*)lds_raw;
            int tid_ = threadIdx.x, G_ = gridDim.x, bx_ = blockIdx.x; asm volatile("" : "+v"(tid_), "+s"(G_), "+s"(bx_));
            const int tid = tid_, lane = tid & 63, wave = __builtin_amdgcn_readfirstlane(tid >> 6);
            const int G = G_, bx = bx_, vcu = (G % 8 == 0) ? (bx % 8) * (G / 8) + bx / 8 : bx;
            const int gw = vcu * NWAVES + wave, NGW = G * NWAVES;
            unsigned char* ws = WS_PTR();
            bf16* MIX = (bf16*)(ws + WS_MIX);
            const bf16* KM = (const bf16*)(ws + WS_KM) + (size_t)l * NB * NMEM * 256; const bf16* VM = (const bf16*)(ws + WS_VM) + (size_t)l * NB * NMEM * 256;
            for (int rep_ = 0; rep_ < REP_A; ++rep_)
            for (int blk = vcu; blk < T / 128; blk += G)
                mixa::unit(lds, blk, GRP(G_AU), GRP(G_AV), GRP(G_AG), IN_PTR(6) + l * GW, IN_PTR(7) + l * GW, IN_PTR(8) + (size_t)l * 4 * 128 * 128, IN_PTR(9) + l * 4 * 128, MIX, tid);
            __syncthreads();
            for (int rep_ = 0; rep_ < REP_B; ++rep_)
            {
                att::fill_bias(lds, IN_PTR(10) + (size_t)l * 4 * 257, tid);
                att::Cfg cfg{GRP(G_BQ), GRP(G_BK), GRP(G_BV), GRP(G_BG), MIX, 256};
                for (int u = vcu; u < NB * 64; u += G) { const int b = u >> 6, c = u & 63, kt0 = c >= 8 ? c - 8 : 0;
                    att::unit<0>(lds, cfg, b * S + c * 64, (size_t)b * S + kt0 * 64, c - kt0 + 1, (c - kt0) * 64, tid); }
            }
            for (int rep_ = 0; rep_ < REP_M; ++rep_)
            {
                att::Cfg cfg{GRP(G_MQ), KM, VM, GRP(G_MG), MIX, 768};
                for (int u = vcu; u < NB * 64; u += G) { const int b = u >> 6, c = u & 63;
                    att::unit<2>(lds, cfg, b * S + c * 64, (size_t)b * NMEM, NMEM / 64, 0, tid); }
            }
#ifdef DEBUG_CMP
            if (l == 0) {
                __syncthreads();
                bf16* MIXR = (bf16*)(ws + 406 * MiB);
                LAS float* sc = (LAS float*)(lds + RING_OFF + wave * 16384); LAS float* qs = (LAS float*)(lds + SCR_OFF + wave * 256);
                const float* brel = IN_PTR(10);
                for (int it = gw; it < T * 4; it += NGW) attn_wave<0>(it >> 2, it & 3, GRP(G_BQ), GRP(G_BK), GRP(G_BV), GRP(G_BG), MIXR, 256, brel, sc, qs, nullptr, 0u, 0, lane, 0.6931471805599453f);
                for (int it = gw; it < T * 4; it += NGW) attn_wave<2>(it >> 2, it & 3, GRP(G_MQ), KM, VM, GRP(G_MG), MIXR, 768, nullptr, sc, qs, nullptr, 0u, 0, lane, 0.6931471805599453f);
            }
#endif
            __syncthreads();
            for (int rep_ = 0; rep_ < REP_C; ++rep_)
            {
                att::fill_bias(lds, (const float*)(ws + WS_TBL), tid);
                att::Cfg cfg{GRP(G_CQ), GRP(G_CK), GRP(G_CV), GRP(G_CG), MIX, 512};
                for (int u = vcu; u < NB * 32; u += G) { const int b = u >> 5, j = u & 31;
                    for (int side = 0; side < 2; ++side) { const int c = side ? 63 - j : j;
                        for (int r1_ = 0; r1_ < REP_C1; ++r1_)
                        c1::chunk(lds, (const bf16*)(ws + WS_IQ), (const bf16*)(ws + WS_IK), (const float*)(ws + WS_IW), b, c, tid);
#ifdef DEBUG_CMP
                        if (l == 0) { unsigned* bmg = (unsigned*)(ws + 470 * MiB); const LAS unsigned* bml = (const LAS unsigned*)(lds + att::L_BM);
                            for (int i = tid; i < 64 * 128; i += 512) { const int q = i >> 7, w = i & 127; bmg[((size_t)b * S + c * 64 + q) * 128 + w] = w < 2 * (c + 1) ? bml[q * att::BM_STRIDE + w] : 0u; } }
#endif
                        for (int r2_ = 0; r2_ < REP_C2; ++r2_)
                        att::unit<1>(lds, cfg, b * S + c * 64, (size_t)b * S, c + 1, c * 64, tid); } }
            }
        }
#endif
        GRID_BAR();
#ifdef DEBUG_CMP
        if (l == 0) {
            int tid_ = threadIdx.x, G_ = gridDim.x, bx_ = blockIdx.x; asm volatile("" : "+v"(tid_), "+s"(G_), "+s"(bx_));
            const int tid = tid_, lane = tid & 63, wave = __builtin_amdgcn_readfirstlane(tid >> 6);
            const int G = G_, bx = bx_, vcu = (G % 8 == 0) ? (bx % 8) * (G / 8) + bx / 8 : bx;
            const int gw = vcu * NWAVES + wave, NGW = G * NWAVES;
            unsigned char* ws = WS_PTR(); const bf16* MIX = (const bf16*)(ws + WS_MIX); bf16* MIXR = (bf16*)(ws + 406 * MiB);
            {   LAS unsigned char* lds = (LAS unsigned char*)lds_raw;
                for (int token = bx; token < T; token += G) mixer_c_token(token, (const bf16*)(ws + WS_IQ), (const bf16*)(ws + WS_IK), (const float*)(ws + WS_IW), GRP(G_CQ), GRP(G_CK), GRP(G_CV), GRP(G_CG), MIXR, (const float*)(ws + WS_TBL), lds, tid,
                                                                          0.6931471805599453f, (const unsigned*)(ws + 470 * MiB), (float*)(ws + WS_CTL) + 2048); }
            GRID_BAR();
                float* acc = (float*)(ws + WS_CTL) + 2048;
                for (int seg = 1; seg < 4; ++seg) {
                    float sd = 0.f, sr = 0.f;
                    for (int m = gw; m < T; m += NGW) for (int j = 0; j < 4; ++j) { const size_t idx = (size_t)m * D + seg * 256 + lane * 4 + j; const float a = bf2f(MIX[idx]), r = bf2f(MIXR[idx]); sd += (a - r) * (a - r); sr += r * r; }
                    sd = wave_sum(sd); sr = wave_sum(sr);
                    if (lane == 0) { atomicAdd(acc + 2 * seg, sd); atomicAdd(acc + 2 * seg + 1, sr); }
                }
        }
#endif
#ifndef NO_P3
        {
            unsigned char* ws = WS_PTR();
            pg8::Gemm g{(const bf16*)(ws + WS_MIX), (const bf16*)(ws + WS_WOUT) + (size_t)l * D * D, T, D, D}; pg8::StaticOrder SO; SO.init(T, D, gridDim.x, blockIdx.x);
            pg8::EpiResid E{OUT_PTR(), IN_PTR(14) + l * D};
            pg8::gemm_phase<pg8::EpiResid, pg8::StaticOrder, true, true>((LAS unsigned char*)lds_raw + RING_OFF, g, SO, E);
        }
#endif
        GRID_BAR();
        {
            int tid_ = threadIdx.x, G_ = gridDim.x, bx_ = blockIdx.x; asm volatile("" : "+v"(tid_), "+s"(G_), "+s"(bx_));
            const int tid = tid_, lane = tid & 63, wave = __builtin_amdgcn_readfirstlane(tid >> 6);
            const int G = G_, bx = bx_, vcu = (G % 8 == 0) ? (bx % 8) * (G / 8) + bx / 8 : bx;
            const int gw = vcu * NWAVES + wave, NGW = G * NWAVES;
            float* out = OUT_PTR(); bf16* HB = (bf16*)(WS_PTR() + WS_HB); const float* g = IN_PTR(15) + l * D; const float* b = IN_PTR(16) + l * D;
            for (int m = gw; m < T; m += NGW) ln_row(out + (size_t)m * D, out + (size_t)m * D, HB + (size_t)m * D, g, b, lane);
        }
        if (l == 0) GRID_BAR();
    }
#ifdef DEBUG_CMP
    GRID_BAR();
    if (blockIdx.x == 0 && threadIdx.x < 5) { const float* acc = (const float*)(WS_PTR() + WS_CTL) + 2048; const int seg = threadIdx.x; const float sd = acc[2 * seg], sr = acc[2 * seg + 1];
        if (sr > 0.f) OUT_PTR()[seg] = 1000.f * sqrtf(sd / sr); }
#endif
}

extern "C" void kernel_launch(void* const* d_in, const int* in_sizes, int n_in, void* d_out, int out_size, void* d_ws, size_t ws_size, hipStream_t stream) {
    static int grid = 0;
    if (grid == 0) {
        if (n_in != 17 || out_size != T * D || ws_size < WS_END) { fprintf(stderr, "kernel_launch: unexpected n_in %d / out_size %d / ws_size %zu; nothing launched\n", n_in, out_size, ws_size); grid = -1; return; }
        int dev = 0, cus = 0, per_cu = 0;
        if (hipGetDevice(&dev) != hipSuccess || hipDeviceGetAttribute(&cus, hipDeviceAttributeMultiprocessorCount, dev) != hipSuccess) { grid = -1; return; }
        if (hipFuncSetAttribute((const void*)mk_fwd, hipFuncAttributeMaxDynamicSharedMemorySize, LDS_BYTES) != hipSuccess) { fprintf(stderr, "kernel_launch: hipFuncSetAttribute failed\n"); grid = -1; return; }
        if (hipOccupancyMaxActiveBlocksPerMultiprocessor(&per_cu, (const void*)mk_fwd, NWAVES * 64, LDS_BYTES) != hipSuccess || per_cu < 1) { fprintf(stderr, "kernel_launch: occupancy query says %d blocks per CU; nothing launched\n", per_cu); (void)hipGetLastError(); grid = -1; return; }
        grid = cus;
    }
    if (grid < 0) return;
    if (hipMemsetAsync((char*)d_ws + WS_CTL, 0, CTL_ZERO_BYTES, stream) != hipSuccess) { fprintf(stderr, "kernel_launch: memset failed\n"); return; }
    Args a{};
    for (int i = 0; i < 17; ++i) a.in[i] = (const float*)d_in[i];
    a.out = (float*)d_out; a.ws = (unsigned char*)d_ws;
    hipLaunchKernelGGL(mk_fwd, dim3(grid), dim3(NWAVES * 64), LDS_BYTES, stream, a);
}
```

```cpp
#include <hip/hip_runtime.h>
#include <cstdio>
#include <cstdint>
namespace pg8 {
#define PG8_LAS __attribute__((address_space(3)))
typedef unsigned short bf16_t;
typedef short bf16x8 __attribute__((ext_vector_type(8)));
typedef float f32x4 __attribute__((ext_vector_type(4)));
typedef unsigned u32x4 __attribute__((ext_vector_type(4)));
constexpr int BM = 256, BK = 64, HALF = 128, HTB = HALF * BK * 2  , STAGE_BYTES = 8 * HTB, NXCD = 8, WGM = 8;

__host__ __device__ __forceinline__ int lds_byte(int r, int c) { const int st = (r >> 4) * 2 + (c >> 5), rr = r & 15, cc = c & 31, ob = rr * 64 + cc * 2; return st * 1024 + (ob ^ (((ob >> 9) & 1) << 5)); }
__host__ __device__ __forceinline__ void stage_rc(int b, int& R, int& C) { const int st = b / 1024, sb = b % 1024, swz = sb ^ (((sb >> 9) & 1) << 5); R = (st >> 1) * 16 + swz / 64; C = (st & 1) * 32 + (swz % 64) / 2; }
__host__ __device__ __forceinline__ int perm32(int rho) { const int n = rho >> 4, i = rho & 15; return 8 * (i >> 2) + 4 * n + (i & 3); }

struct Unit { int pm, pn; };
struct Gemm { const bf16_t* A; const bf16_t* Bt; int M, N, K; };

struct StaticOrder {
    int nM, nN, nwg, G, c;
    __host__ __device__ void init(int M, int N, int G_, int c_) { nM = M / BM; nN = N / BM; nwg = nM * nN; G = G_; c = c_; }
    __host__ __device__ bool next(int i, Unit& u) const {
        const long L = (long)i * G + c; if (L >= nwg) return false;
        int wgid = (int)L; { const int q = nwg / NXCD, r = nwg % NXCD, xcd = wgid % NXCD, off = wgid / NXCD; wgid = (xcd < r ? xcd * (q + 1) : r * (q + 1) + (xcd - r) * q) + off; }
        const int nig = WGM * nN, gid = wgid / nig, fm = gid * WGM, gsz = (nM - fm) < WGM ? (nM - fm) : WGM;
        u.pm = fm + ((wgid % nig) % gsz); u.pn = (wgid % nig) / gsz; return true;
    }
    __device__ __forceinline__ void a_ready(const Unit&) const {}
    __device__ __forceinline__ void done(const Unit&) const {}
};

__device__ __forceinline__ unsigned cvt_pk_bf16(float lo, float hi) { unsigned r; asm volatile("v_cvt_pk_bf16_f32 %0, %1, %2" : "=v"(r) : "v"(lo), "v"(hi)); return r; }
typedef float f32x2 __attribute__((ext_vector_type(2)));
template <class Epi, class Sched, bool ALIGN_EPI = false, bool SP2 = false>
__device__ __forceinline__ void gemm_phase(PG8_LAS unsigned char* lds, const Gemm g, const Sched& S, const Epi& E) {
    const int tid = threadIdx.x, wid = __builtin_amdgcn_readfirstlane(tid >> 6), lane = tid & 63, wr = wid >> 2, wc = wid & 3, fr = lane & 15, fq = lane >> 4;
    const int K = g.K, nt = K / BK;
    unsigned voffA[2], voffB[2];
#pragma unroll
    for (int i = 0; i < 2; ++i) { int R, C; stage_rc(tid * 16 + i * 8192, R, C); const int Rb = Epi::PERM ? ((R & ~31) + perm32(R & 31)) : R;
        voffA[i] = (unsigned)(R * K + C) * 2u; voffB[i] = (unsigned)(Rb * K + C) * 2u; }
    const size_t kstep = (size_t)(BK * 2);
    const size_t hstep = (size_t)HALF * K * 2;
    const size_t tstep = 2 * hstep;
    const unsigned ldsw = (unsigned)wid * 1024u;
    const int aoff = lds_byte(wr * 64 + fr, fq * 8), boff = lds_byte(wc * 32 + fr, fq * 8);
#define PG8_SA(b, h) (((b) * 2 + (h)) * HTB)
#define PG8_SB(b, h) ((4 + (b) * 2 + (h)) * HTB)
#define PG8_STAGE(bufoff, gbase, voff) do { _Pragma("unroll") for (int _i = 0; _i < 2; ++_i) \
        __builtin_amdgcn_global_load_lds((const unsigned*)((const char*)(gbase) + (voff)[_i]), (PG8_LAS unsigned*)(lds + (bufoff) + ldsw + _i * 8192), 16, 0, 0); } while (0)
#define PG8_LDA(dst, b, h) do { _Pragma("unroll") for (int m = 0; m < 4; ++m) _Pragma("unroll") for (int k = 0; k < 2; ++k) dst[m][k] = *(const PG8_LAS bf16x8*)(lds + PG8_SA(b, h) + aoff + m * 2048 + k * 1024); } while (0)
#define PG8_LDB(dst, b, h) do { _Pragma("unroll") for (int n = 0; n < 2; ++n) _Pragma("unroll") for (int k = 0; k < 2; ++k) dst[n][k] = *(const PG8_LAS bf16x8*)(lds + PG8_SB(b, h) + boff + n * 2048 + k * 1024); } while (0)
#define PG8_MMA(ai, bj, At, Bt) do { __builtin_amdgcn_s_setprio(1); _Pragma("unroll") for (int m = 0; m < 4; ++m) _Pragma("unroll") for (int n = 0; n < 2; ++n) _Pragma("unroll") for (int k = 0; k < 2; ++k) \
        acc[ai][bj][m][n] = __builtin_amdgcn_mfma_f32_16x16x32_bf16(Bt[n][k], At[m][k], acc[ai][bj][m][n], 0, 0, 0); __builtin_amdgcn_s_setprio(0); } while (0)
#define PG8_WAIT_V(n) asm volatile("s_waitcnt vmcnt(" #n ")" ::: "memory")
#define PG8_WAIT_L(n) asm volatile("s_waitcnt lgkmcnt(" #n ")" ::: "memory")
#define PG8_BAR __builtin_amdgcn_s_barrier()
#define PG8_SCHED __builtin_amdgcn_sched_barrier(0)
    Unit cur, nxt; int ui = 0;
    if (!S.next(0, cur)) return;
    f32x4 acc[2][2][4][2];
#pragma unroll
    for (int a = 0; a < 2; ++a)
#pragma unroll
        for (int b = 0; b < 2; ++b)
#pragma unroll
            for (int m = 0; m < 4; ++m)
#pragma unroll
                for (int n = 0; n < 2; ++n) acc[a][b][m][n] = (f32x4){0.f, 0.f, 0.f, 0.f};
    bf16x8 At[4][2], B0[2][2], B1[2][2];
    const char* cA = (const char*)g.A + (size_t)cur.pm * tstep; const char* cB = (const char*)g.Bt + (size_t)cur.pn * tstep;
    S.a_ready(cur);
    if constexpr (SP2) {
        PG8_STAGE(PG8_SB(0, 0), cB, voffB); PG8_STAGE(PG8_SB(0, 1), cB + hstep, voffB); PG8_STAGE(PG8_SA(0, 0), cA, voffA); PG8_STAGE(PG8_SA(0, 1), cA + hstep, voffA);
        if (wr == 1) PG8_BAR;
        PG8_WAIT_V(2); PG8_BAR;
        PG8_STAGE(PG8_SB(1, 0), cB + kstep, voffB); PG8_STAGE(PG8_SA(1, 0), cA + kstep, voffA); PG8_STAGE(PG8_SB(1, 1), cB + hstep + kstep, voffB);
        PG8_WAIT_V(6); PG8_BAR;
    } else {
        PG8_STAGE(PG8_SB(0, 0), cB, voffB); PG8_STAGE(PG8_SA(0, 0), cA, voffA); PG8_STAGE(PG8_SB(0, 1), cB + hstep, voffB); PG8_STAGE(PG8_SA(0, 1), cA + hstep, voffA);
        if (wr == 1) PG8_BAR;
        PG8_WAIT_V(4); PG8_BAR;
        PG8_STAGE(PG8_SB(1, 0), cB + kstep, voffB); PG8_STAGE(PG8_SA(1, 0), cA + kstep, voffA); PG8_STAGE(PG8_SB(1, 1), cB + hstep + kstep, voffB);
        PG8_WAIT_V(6); PG8_BAR;
    }
    for (;;) {
        const bool has_next = S.next(ui + 1, nxt);
        const char* nA = has_next ? (const char*)g.A + (size_t)nxt.pm * tstep : cA; const char* nB = has_next ? (const char*)g.Bt + (size_t)nxt.pn * tstep : cB;
        for (int t = 0; t < nt; t += 2) {
            const bool last = (t == nt - 2);
            const char* a1 = cA + (size_t)(t + 1) * kstep;
            const char* a2 = last ? nA : cA + (size_t)(t + 2) * kstep; const char* b2 = last ? nB : cB + (size_t)(t + 2) * kstep;
            const char* a3 = a2 + kstep; const char* b3 = b2 + kstep;
            if (last && has_next) S.a_ready(nxt);
            if constexpr (SP2) {
            PG8_LDB(B0, 0, 0); PG8_LDB(B1, 0, 1); PG8_SCHED; PG8_LDA(At, 0, 0); PG8_STAGE(PG8_SA(1, 1), a1 + hstep, voffA);
            PG8_WAIT_V(8); PG8_WAIT_L(0); PG8_BAR; PG8_MMA(0, 0, At, B0); PG8_MMA(0, 1, At, B1); PG8_BAR; PG8_SCHED;
            PG8_LDA(At, 0, 1); PG8_STAGE(PG8_SB(0, 0), b2, voffB); PG8_STAGE(PG8_SB(0, 1), b2 + hstep, voffB); PG8_STAGE(PG8_SA(0, 0), a2, voffA);
            PG8_WAIT_V(8); PG8_WAIT_L(0); PG8_BAR; PG8_MMA(1, 0, At, B0); PG8_MMA(1, 1, At, B1); PG8_BAR; PG8_SCHED;
            PG8_LDB(B0, 1, 0); PG8_LDB(B1, 1, 1); PG8_SCHED; PG8_LDA(At, 1, 0); PG8_STAGE(PG8_SA(0, 1), a2 + hstep, voffA);
            PG8_WAIT_V(8); PG8_WAIT_L(0); PG8_BAR; PG8_MMA(0, 0, At, B0); PG8_MMA(0, 1, At, B1); PG8_BAR; PG8_SCHED;
            PG8_LDA(At, 1, 1); PG8_STAGE(PG8_SB(1, 0), b3, voffB); PG8_STAGE(PG8_SB(1, 1), b3 + hstep, voffB); PG8_STAGE(PG8_SA(1, 0), a3, voffA);
            PG8_WAIT_V(8); PG8_WAIT_L(0); PG8_BAR; PG8_MMA(1, 0, At, B0); PG8_MMA(1, 1, At, B1); PG8_BAR; PG8_SCHED;
            } else {
            PG8_LDB(B0, 0, 0); PG8_SCHED; PG8_LDA(At, 0, 0); PG8_STAGE(PG8_SA(1, 1), a1 + hstep, voffA);
            PG8_WAIT_L(8); PG8_BAR; PG8_WAIT_L(0); PG8_MMA(0, 0, At, B0); PG8_BAR; PG8_SCHED;
            PG8_LDB(B1, 0, 1); PG8_STAGE(PG8_SB(0, 0), b2, voffB);
            PG8_BAR; PG8_WAIT_L(0); PG8_MMA(0, 1, At, B1); PG8_BAR;
            PG8_LDA(At, 0, 1); PG8_STAGE(PG8_SA(0, 0), a2, voffA);
            PG8_BAR; PG8_WAIT_L(0); PG8_MMA(1, 0, At, B0); PG8_BAR; PG8_SCHED;
            PG8_STAGE(PG8_SB(0, 1), b2 + hstep, voffB);
            PG8_WAIT_V(6); PG8_BAR; PG8_MMA(1, 1, At, B1); PG8_BAR;
            PG8_LDB(B0, 1, 0); PG8_SCHED; PG8_LDA(At, 1, 0); PG8_STAGE(PG8_SA(0, 1), a2 + hstep, voffA);
            PG8_WAIT_L(8); PG8_BAR; PG8_WAIT_L(0); PG8_MMA(0, 0, At, B0); PG8_BAR; PG8_SCHED;
            PG8_LDB(B1, 1, 1); PG8_STAGE(PG8_SB(1, 0), b3, voffB);
            PG8_BAR; PG8_WAIT_L(0); PG8_MMA(0, 1, At, B1); PG8_BAR;
            PG8_LDA(At, 1, 1); PG8_STAGE(PG8_SA(1, 0), a3, voffA);
            PG8_BAR; PG8_WAIT_L(0); PG8_MMA(1, 0, At, B0); PG8_BAR; PG8_SCHED;
            PG8_STAGE(PG8_SB(1, 1), b3 + hstep, voffB);
            PG8_WAIT_V(6); PG8_BAR; PG8_MMA(1, 1, At, B1); PG8_BAR;
            }
        }
        if constexpr (ALIGN_EPI) { if (wr == 0) PG8_BAR; }
        if constexpr (!Epi::AFTER_DRAIN) { E(acc, cur, wr, wc, fr, fq); S.done(cur); }
        if (!has_next) break;
#pragma unroll
        for (int a = 0; a < 2; ++a)
#pragma unroll
            for (int b = 0; b < 2; ++b)
#pragma unroll
                for (int m = 0; m < 4; ++m)
#pragma unroll
                    for (int n = 0; n < 2; ++n) acc[a][b][m][n] = (f32x4){0.f, 0.f, 0.f, 0.f};
        cur = nxt; cA = nA; cB = nB; ++ui;
        if constexpr (ALIGN_EPI) { if (wr == 1) PG8_BAR; }
    }
    PG8_WAIT_V(0);
    if constexpr (!ALIGN_EPI) { if (wr == 0) PG8_BAR; }
    PG8_BAR;
    if constexpr (Epi::AFTER_DRAIN) { E.fused(acc, cur, wr, wc, fr, fq, lds, wid, lane); S.done(cur); }
#undef PG8_SA
#undef PG8_SB
#undef PG8_STAGE
#undef PG8_LDA
#undef PG8_LDB
#undef PG8_MMA
#undef PG8_WAIT_V
#undef PG8_WAIT_L
#undef PG8_BAR
#undef PG8_SCHED
}
}
typedef unsigned short bf16;
constexpr int NB = 8, S = 4096, D = 1024, T = NB * S, GW = 256, DIN = 3912, DINP = 4096, NMEM = 256;
constexpr float LN_EPS = 1e-5f;
constexpr float ALPHA = 1.41421356237309515f;
constexpr size_t MiB = 1u << 20;
constexpr size_t WS_CTL = 0, CTL_ZERO_BYTES = 1 * MiB;
constexpr size_t WS_WIN = 2 * MiB;
constexpr size_t WS_WOUT = 18 * MiB;
constexpr size_t WS_TBL = 22 * MiB;
constexpr size_t WS_WMT = 23 * MiB;
constexpr size_t WS_KM = 25 * MiB;
constexpr size_t WS_VM = 27 * MiB;
constexpr size_t WS_HB = 32 * MiB;
constexpr size_t WS_MIX = 96 * MiB;
constexpr size_t WS_MEMB = WS_MIX;
constexpr size_t WS_P13 = 160 * MiB;
constexpr size_t WS_IQ = 368 * MiB;
constexpr size_t WS_IK = 400 * MiB;
constexpr size_t WS_IW = 404 * MiB;
constexpr size_t WS_BM = 406 * MiB;
constexpr size_t WS_END = 422 * MiB;
enum Grp { G_AU = 0, G_AV, G_AG, G_BQ, G_BK, G_BV, G_BG, G_CQ, G_CK, G_CV, G_CG, G_MQ, G_MG };
constexpr int CW_BAR = 4096;

__device__ __forceinline__ float bf2f(bf16 v) { return __uint_as_float((unsigned)v << 16); }
__device__ __forceinline__ bf16 f2bf(float f) { unsigned u = __float_as_uint(f); return (bf16)((u + 0x7fffu + ((u >> 16) & 1u)) >> 16); }
__device__ __forceinline__ float fast_sigmoid(float x) { return __builtin_amdgcn_rcpf(1.f + __builtin_amdgcn_exp2f(-1.4426950408889634f * x)); }
__device__ __forceinline__ float gelu_tanh(float x) { const float u = 0.7978845608028654f * (x + 0.044715f * x * x * x); return x * fast_sigmoid(2.f * u); }
__device__ __forceinline__ float silu(float x) { return x * fast_sigmoid(x); }
__device__ __forceinline__ float wave_sum(float v) {
#pragma unroll
    for (int o = 1; o < 64; o <<= 1) v += __shfl_xor(v, o);
    return v;
}
__device__ __forceinline__ float wave_max(float v) {
#pragma unroll
    for (int o = 1; o < 64; o <<= 1) v = fmaxf(v, __shfl_xor(v, o));
    return v;
}
__host__ __device__ __forceinline__ int perm_col(int col) {
    if (col < 3328) return col;
    if (col < 3392) return 3840 + (col - 3328);
    if (col < 3400) return 3904 + (col - 3392);
    if (col < 3656) return 3328 + (col - 3400);
    return 3584 + (col - 3656);
}

namespace pg8 {
__device__ __forceinline__ f32x4 act4(f32x4 v, int mode) {
    if (mode == 1) { v[0] = gelu_tanh(v[0]); v[1] = gelu_tanh(v[1]); v[2] = gelu_tanh(v[2]); v[3] = gelu_tanh(v[3]); }
    else if (mode == 2) { v[0] = silu(v[0]); v[1] = silu(v[1]); v[2] = silu(v[2]); v[3] = silu(v[3]); }
    else if (mode == 3) { v = v * 0.125f; }
    else if (mode == 4) { v = v * (0.125f * 1.4426950408889634f); }
    return v;
}
struct EpiRoute {
    static constexpr bool PERM = true, AFTER_DRAIN = false;
    bf16_t* p13; bf16_t* iq; bf16_t* ik; float* iw; const float* bias;
    __device__ __forceinline__ void operator()(const f32x4 (&acc)[2][2][4][2], const Unit& u, int wr, int wc, int fr, int fq) const {
        const int pn = u.pn, row0 = u.pm * BM + wr * 64 + fr, cl0 = wc * 32 + 8 * fq;
        f32x4 bv[2][2];
#pragma unroll
        for (int bj = 0; bj < 2; ++bj)
#pragma unroll
            for (int n = 0; n < 2; ++n) bv[bj][n] = *(const f32x4*)(bias + pn * BM + bj * HALF + cl0 + 4 * n);
        if (pn == 15) {
#pragma unroll
            for (int ai = 0; ai < 2; ++ai)
#pragma unroll
                for (int m = 0; m < 4; ++m) { const size_t row = (size_t)(row0 + ai * HALF + m * 16);
                    const f32x4 v0 = acc[ai][0][m][0] + bv[0][0], v1 = acc[ai][0][m][1] + bv[0][1];
                    if (wc < 2) { u32x4 w; w.x = cvt_pk_bf16(v0[0], v0[1]); w.y = cvt_pk_bf16(v0[2], v0[3]); w.z = cvt_pk_bf16(v1[0], v1[1]); w.w = cvt_pk_bf16(v1[2], v1[3]); *(u32x4*)(ik + row * 64 + cl0) = w; }
                    else if (wc == 2 && fq == 0) { *(f32x4*)(iw + row * 8) = v0; *(f32x4*)(iw + row * 8 + 4) = v1; } }
            return;
        }
        bf16_t* base; int ldc, mode;
        if (pn <= 10) { base = p13 + (size_t)pn * T * GW; ldc = GW; mode = (pn == G_AU || pn == G_AV) ? 1 : (pn == G_AG || pn == G_BG || pn == G_CG) ? 2 : (pn == G_BQ || pn == G_CQ) ? 4 : 0; }
        else if (pn <= 12) { base = iq + (pn - 11) * 256; ldc = 512; mode = 0; }
        else if (pn == 13) { base = p13 + (size_t)G_MQ * T * GW; ldc = GW; mode = 4; }
        else { base = p13 + (size_t)G_MG * T * GW; ldc = GW; mode = 2; }
#pragma unroll
        for (int ai = 0; ai < 2; ++ai)
#pragma unroll
            for (int m = 0; m < 4; ++m) { bf16_t* rowp = base + (size_t)(row0 + ai * HALF + m * 16) * ldc + cl0;
#pragma unroll
                for (int bj = 0; bj < 2; ++bj) { const f32x4 v0 = act4(acc[ai][bj][m][0] + bv[bj][0], mode), v1 = act4(acc[ai][bj][m][1] + bv[bj][1], mode);
                    u32x4 w; w.x = cvt_pk_bf16(v0[0], v0[1]); w.y = cvt_pk_bf16(v0[2], v0[3]); w.z = cvt_pk_bf16(v1[0], v1[1]); w.w = cvt_pk_bf16(v1[2], v1[3]);
                    *(u32x4*)(rowp + bj * HALF) = w; } }
    }
};
struct EpiResid {
    static constexpr bool PERM = false, AFTER_DRAIN = false;
    float* out; const float* bias;
    __device__ __forceinline__ void operator()(const f32x4 (&acc)[2][2][4][2], const Unit& u, int wr, int wc, int fr, int fq) const {
        const int col0 = u.pn * BM + wc * 32 + 4 * fq;
#pragma unroll
        for (int ai = 0; ai < 2; ++ai)
#pragma unroll
            for (int m = 0; m < 4; ++m) { float* rowp = out + (size_t)(u.pm * BM + ai * HALF + wr * 64 + m * 16 + fr) * D + col0;
#pragma unroll
                for (int bj = 0; bj < 2; ++bj)
#pragma unroll
                    for (int n = 0; n < 2; ++n) { float* p = rowp + bj * HALF + n * 16; const f32x4 bv = *(const f32x4*)(bias + col0 + bj * HALF + n * 16);
                        const f32x4 h = *(const f32x4*)p; *(f32x4*)p = h * ALPHA + acc[ai][bj][m][n] + bv; } }
    }
};
struct EpiKV {
    static constexpr bool PERM = true, AFTER_DRAIN = false;
    bf16_t* km; bf16_t* vm;
    __device__ __forceinline__ void operator()(const f32x4 (&acc)[2][2][4][2], const Unit& u, int wr, int wc, int fr, int fq) const {
        bf16_t* base = km + (size_t)(u.pn & 1) * ((WS_VM - WS_KM) / 2) + (size_t)(u.pn >> 1) * NB * NMEM * 256;
        const int row0 = u.pm * BM + wr * 64 + fr, cl0 = wc * 32 + 8 * fq;
#pragma unroll
        for (int ai = 0; ai < 2; ++ai)
#pragma unroll
            for (int m = 0; m < 4; ++m) { bf16_t* rowp = base + (size_t)(row0 + ai * HALF + m * 16) * 256 + cl0;
#pragma unroll
                for (int bj = 0; bj < 2; ++bj) { const f32x4 v0 = acc[ai][bj][m][0], v1 = acc[ai][bj][m][1];
                    u32x4 w; w.x = cvt_pk_bf16(v0[0], v0[1]); w.y = cvt_pk_bf16(v0[2], v0[3]); w.z = cvt_pk_bf16(v1[0], v1[1]); w.w = cvt_pk_bf16(v1[2], v1[3]);
                    *(u32x4*)(rowp + bj * HALF) = w; } }
    }
};
}
#define GAS __attribute__((address_space(1)))
#define LAS __attribute__((address_space(3)))
typedef unsigned short bf16;
typedef unsigned v4u __attribute__((ext_vector_type(4)));
typedef float f32x4 __attribute__((ext_vector_type(4)));
typedef short bf16x8 __attribute__((ext_vector_type(8)));
typedef GAS unsigned gu32;
typedef GAS unsigned long long gu64;
#define RLX_AGENT __ATOMIC_RELAXED, __HIP_MEMORY_SCOPE_AGENT
#define LDS_WAIT() asm volatile("s_waitcnt lgkmcnt(0)" ::: "memory")
#define VM_WAIT() asm volatile("s_waitcnt vmcnt(0)" ::: "memory")
__device__ __forceinline__ unsigned long long rt() { return __builtin_amdgcn_s_memrealtime(); }
__device__ __forceinline__ unsigned pk2(float lo, float hi) { return (unsigned)f2bf(lo) | ((unsigned)f2bf(hi) << 16); }

#define XB_TMO      128
#define XB_XCNT(j)  (256  + 64 * (j))
#define XB_XSUB(j)  (1280 + 64 * (j))
#define XB_XGEN(j)  (2304 + 64 * (j))
#define XB_TOP      3328
#define XB_TOPGEN   3392
#define XCD_BAR_WORDS 3456
#define XB_SPIN_CAP (1u << 18)

__device__ __forceinline__ unsigned xb_ld(unsigned* p)              { return __hip_atomic_load(p, __ATOMIC_RELAXED, __HIP_MEMORY_SCOPE_AGENT); }
__device__ __forceinline__ unsigned xb_add(unsigned* p, unsigned v) { return __hip_atomic_fetch_add(p, v, __ATOMIC_RELAXED, __HIP_MEMORY_SCOPE_AGENT); }
__device__ __forceinline__ unsigned xb_xcc_id() { return (unsigned)__builtin_amdgcn_s_getreg((3 << 11) | 20) & 0xFu; }
#define XB_SPIN(cond, bar) do { unsigned _sp = 0; while (cond) { __builtin_amdgcn_s_sleep(1); \
    if ((++_sp & 255u) == 0u) { if (xb_ld(&(bar)[XB_TMO])) break; if (_sp > XB_SPIN_CAP) { atomicAdd(&(bar)[XB_TMO], 1u); break; } } } } while (0)

struct XcdBarrier {
    unsigned* bar; unsigned x;
    volatile LAS unsigned* st;
};

__device__ __forceinline__ XcdBarrier xcd_barrier_post(unsigned* bar, volatile LAS unsigned* st) {
    XcdBarrier b; b.bar = bar; b.x = xb_xcc_id(); b.st = st;
    if (threadIdx.x == 0) (void)xb_add(&bar[XB_XCNT(b.x)], 1u);
    return b;
}
__device__ __forceinline__ void xcd_barrier_complete(unsigned* bar, unsigned x, unsigned& nloc, unsigned& nx) {
    const unsigned G = gridDim.x * gridDim.y * gridDim.z;
    unsigned sum, cnt, mine, sp = 0u;
    for (;;) {
        sum = 0u; cnt = 0u; mine = 0u;
#pragma unroll
        for (unsigned j = 0; j < 16; ++j) { const unsigned c = xb_ld(&bar[XB_XCNT(j)]); sum += c; cnt += (c > 0u) ? 1u : 0u; mine = (j == x) ? c : mine; }
        if (sum == G) break;
        __builtin_amdgcn_s_sleep(1);
        if ((++sp & 255u) == 0u) { if (xb_ld(&bar[XB_TMO])) break; if (sp > XB_SPIN_CAP) { atomicAdd(&bar[XB_TMO], 1u); break; } }
    }
    nloc = mine > 0u ? mine : 1u; nx = cnt > 0u ? cnt : 1u;
}

__device__ __forceinline__ void xcd_barrier(const XcdBarrier& b) {
    asm volatile("s_waitcnt vmcnt(0)" ::: "memory");
    __syncthreads();
    if (threadIdx.x == 0) {
        unsigned* bar = b.bar;
        __builtin_amdgcn_s_waitcnt(0);
        unsigned nloc = b.st[0], nx = b.st[1];
        if (nloc == 0u) { xcd_barrier_complete(bar, b.x, nloc, nx); b.st[0] = nloc; b.st[1] = nx; }
        const unsigned old = xb_add(&bar[XB_XSUB(b.x)], 1u);
        const unsigned gen = old / nloc;
        if (old + 1u == (gen + 1u) * nloc) {
            __builtin_amdgcn_fence(__ATOMIC_RELEASE, "agent");
            asm volatile("s_waitcnt vmcnt(0)" ::: "memory");
            const unsigned og = xb_add(&bar[XB_TOP], 1u);
            const unsigned tg = og / nx;
            if (og + 1u == (tg + 1u) * nx) xb_add(&bar[XB_TOPGEN], 1u);
            else XB_SPIN(xb_ld(&bar[XB_TOPGEN]) == tg, bar);
            __builtin_amdgcn_fence(__ATOMIC_ACQUIRE, "agent");
            xb_add(&bar[XB_XGEN(b.x)], 1u);
            asm volatile("s_waitcnt vmcnt(0)" ::: "memory");
        } else {
            XB_SPIN(xb_ld(&bar[XB_XGEN(b.x)]) == gen, bar);
            __builtin_amdgcn_fence(__ATOMIC_ACQUIRE, "agent");
            asm volatile("s_waitcnt vmcnt(0)" ::: "memory");
        }
    }
    __syncthreads();
}
namespace att {
typedef short bf16x8 __attribute__((ext_vector_type(8)));
typedef short s16x4 __attribute__((ext_vector_type(4)));
typedef float f32x16 __attribute__((ext_vector_type(16)));
typedef float f32x2_t __attribute__((ext_vector_type(2)));
typedef __bf16 bf16x2_t __attribute__((ext_vector_type(2)));
typedef unsigned u32x4 __attribute__((ext_vector_type(4)));
typedef unsigned u32x2 __attribute__((ext_vector_type(2)));
constexpr int BUFB = 65536, L_V = 32768, L_OST = 0, L_BIAS = 131072, L_WS = L_BIAS + 4352, L_END = L_WS + 8 * 256;
constexpr float LOG2E = 1.4426950408889634f, THR = 8.f;
__device__ __forceinline__ int crow(int r, int hi) { return (r & 3) + 8 * (r >> 2) + 4 * hi; }
__device__ __forceinline__ unsigned cvtpk(float lo, float hi) { f32x2_t v = {lo, hi}; bf16x2_t b = __builtin_convertvector(v, bf16x2_t); return __builtin_bit_cast(unsigned, b); }
__device__ __forceinline__ s16x4 vtr(const LAS unsigned char* p) { typedef short v4i16_t __attribute__((ext_vector_type(4))); return __builtin_bit_cast(s16x4, __builtin_amdgcn_ds_read_tr16_b64_v4i16((LAS v4i16_t*)p)); }
__device__ __forceinline__ float halfmax(float m) { auto rr = __builtin_amdgcn_permlane32_swap(__float_as_uint(m), __float_as_uint(m), false, false); return fmaxf(__uint_as_float(rr[0]), __uint_as_float(rr[1])); }

__device__ __forceinline__ void fill_bias(LAS unsigned char* lds, const float* tbl, int tid) {
    LAS float* bl = (LAS float*)(lds + L_BIAS);
    for (int i = tid; i < 4 * 257; i += 512) { const int h = i / 257; bl[i] = (tbl[i] - tbl[h * 257 + 256]) * LOG2E; }
}

struct Cfg { const bf16* Q; const bf16* K; const bf16* V; const bf16* Gt; bf16* mix; int colofs; };

template <int MODE>
__device__ __forceinline__ void unit(LAS unsigned char* lds, const Cfg& A, int tok0, size_t kvrow0, int ntiles, int delta0, const unsigned* bmg, int tid_in) {
    int tid = tid_in; asm volatile("" : "+v"(tid));
    const int lane = tid & 63, wave = __builtin_amdgcn_readfirstlane(tid >> 6), h = wave >> 1, qh = wave & 1, r32 = lane & 31, hi = lane >> 5;
    const int qloc = 32 * qh + r32;
    unsigned koff[4], voff[4];
#pragma unroll
    for (int j = 0; j < 4; ++j) {
        const int pk = wave * 4 + j, kh = pk >> 3, key = 8 * (pk & 7) + (lane >> 3), chunk = (lane & 7) ^ ((key >> 1) & 7);
        koff[j] = (unsigned)(key * GW + kh * 64 + chunk * 8) * 2u;
        const int vh = pk >> 3, vrem = pk & 7, vkey = 16 * (vrem & 3) + (lane >> 2);
        voff[j] = (unsigned)(vkey * GW + vh * 64 + (vrem >> 2) * 32 + (lane & 3) * 8) * 2u;
    }
    const char* kgb = (const char*)(A.K + kvrow0 * GW); const char* vgb = (const char*)(A.V + kvrow0 * GW);
    const unsigned ldsw = (unsigned)wave * 4096u;
#define ATT_DMA(t_, buf_) do { const size_t tb_ = (size_t)(t_) * 64 * GW * 2; _Pragma("unroll") for (int j = 0; j < 4; ++j) { \
        __builtin_amdgcn_global_load_lds((const unsigned*)(kgb + tb_ + koff[j]), (LAS unsigned*)(lds + (buf_) * BUFB + ldsw + j * 1024), 16, 0, 0); \
        __builtin_amdgcn_global_load_lds((const unsigned*)(vgb + tb_ + voff[j]), (LAS unsigned*)(lds + (buf_) * BUFB + L_V + ldsw + j * 1024), 16, 0, 0); } } while (0)
    asm volatile("s_waitcnt vmcnt(0) lgkmcnt(0)" ::: "memory"); __builtin_amdgcn_s_barrier();
    ATT_DMA(0, 0);
    bf16x8 qr[4];
    { const bf16* qp = A.Q + (size_t)(tok0 + qloc) * GW + h * 64 + 8 * hi;
#pragma unroll
      for (int d0 = 0; d0 < 4; ++d0) qr[d0] = *(const bf16x8*)(qp + 16 * d0); }
    const unsigned* bmrow = bmg + (size_t)(tok0 + qloc) * 128;
    u32x2 mw = {0u, 0u};
    if (MODE == 1) mw = *(const u32x2*)bmrow;
    const int sw = (r32 >> 1) & 7;
    const unsigned kfr = h * 8192 + r32 * 128;
    const unsigned vfr = L_V + h * 8192 + ((lane >> 4) & 1) * 32 + (lane & 3) * 8 + (4 * hi + ((lane & 15) >> 2)) * 64;
    LAS float* wsf = (LAS float*)(lds + L_WS + wave * 256);
    const LAS float* biasL = (const LAS float*)(lds + L_BIAS) + h * 257;
    const bf16x8 ones = {(short)0x3f80, (short)0x3f80, (short)0x3f80, (short)0x3f80, (short)0x3f80, (short)0x3f80, (short)0x3f80, (short)0x3f80};
    f32x16 o0 = {}, o1 = {}, o2 = {};
    float mref = 0.f;
    asm volatile("s_waitcnt vmcnt(0)" ::: "memory"); __builtin_amdgcn_s_barrier();
    for (int t = 0; t < ntiles; ++t) {
        const LAS unsigned char* buf = lds + (t & 1) * BUFB;
        u32x2 mnext = {0u, 0u};
        if (t + 1 < ntiles) { ATT_DMA(t + 1, (t + 1) & 1); if (MODE == 1) mnext = *(const u32x2*)(bmrow + 2 * (t + 1)); }
        f32x16 p0, p1;
#pragma unroll
        for (int r = 0; r < 16; ++r) { p0[r] = -mref; p1[r] = -mref; }
#pragma unroll
        for (int d0 = 0; d0 < 4; ++d0) {
            const LAS unsigned char* kp = buf + kfr + (((2 * d0 + hi) ^ sw) << 4);
            const bf16x8 a0 = *(const LAS bf16x8*)kp, a1 = *(const LAS bf16x8*)(kp + 4096);
            p0 = __builtin_amdgcn_mfma_f32_32x32x16_bf16(a0, qr[d0], p0, 0, 0, 0);
            p1 = __builtin_amdgcn_mfma_f32_32x32x16_bf16(a1, qr[d0], p1, 0, 0, 0);
        }
        if (MODE != 2) {
            const int dl = delta0 - 64 * t;
            if (dl < 192) {
                const int base = dl + qloc + 128;
#pragma unroll
                for (int r = 0; r < 16; ++r) { const int kl = crow(r, hi); int i0 = base - kl, i1 = base - kl - 32; i0 = i0 > 256 ? 256 : i0; i1 = i1 > 256 ? 256 : i1; p0[r] += biasL[i0]; p1[r] += biasL[i1]; }
            }
        }
        float rm = fmaxf(p0[0], p1[0]);
#pragma unroll
        for (int r = 1; r < 16; ++r) rm = fmaxf(rm, fmaxf(p0[r], p1[r]));
        rm = halfmax(rm);
        if (t == 0 || __any(rm > THR)) {
            const float dl = (t == 0) ? rm : fmaxf(rm, 0.f);
            mref += dl;
#pragma unroll
            for (int r = 0; r < 16; ++r) { p0[r] -= dl; p1[r] -= dl; }
            if (t != 0) {
                if (hi == 0) wsf[r32] = __builtin_amdgcn_exp2f(-dl);
                asm volatile("s_waitcnt lgkmcnt(0)" ::: "memory");
#pragma unroll
                for (int g = 0; g < 4; ++g) { const f32x4 a = *(const LAS f32x4*)(wsf + 8 * g + 4 * hi);
#pragma unroll
                    for (int j = 0; j < 4; ++j) { o0[4 * g + j] *= a[j]; o1[4 * g + j] *= a[j]; o2[4 * g + j] *= a[j]; } }
            }
        }
#pragma unroll
        for (int r = 0; r < 16; ++r) { p0[r] = __builtin_amdgcn_exp2f(p0[r]); p1[r] = __builtin_amdgcn_exp2f(p1[r]); }
        if (MODE == 1) {
            const unsigned w0 = mw.x >> (4 * hi), w1 = mw.y >> (4 * hi);
#pragma unroll
            for (int r = 0; r < 16; ++r) { const int bit = (r & 3) + 8 * (r >> 2);
                p0[r] = __uint_as_float(__float_as_uint(p0[r]) & (unsigned)__builtin_amdgcn_sbfe((int)w0, bit, 1));
                p1[r] = __uint_as_float(__float_as_uint(p1[r]) & (unsigned)__builtin_amdgcn_sbfe((int)w1, bit, 1)); }
            mw = mnext;
        }
        u32x4 pw[4];
        pw[0] = (u32x4){cvtpk(p0[0], p0[1]), cvtpk(p0[2], p0[3]), cvtpk(p0[4], p0[5]), cvtpk(p0[6], p0[7])};
        pw[1] = (u32x4){cvtpk(p0[8], p0[9]), cvtpk(p0[10], p0[11]), cvtpk(p0[12], p0[13]), cvtpk(p0[14], p0[15])};
        pw[2] = (u32x4){cvtpk(p1[0], p1[1]), cvtpk(p1[2], p1[3]), cvtpk(p1[4], p1[5]), cvtpk(p1[6], p1[7])};
        pw[3] = (u32x4){cvtpk(p1[8], p1[9]), cvtpk(p1[10], p1[11]), cvtpk(p1[12], p1[13]), cvtpk(p1[14], p1[15])};
#pragma unroll
        for (int ks = 0; ks < 4; ++ks) {
            const bf16x8 pa = __builtin_bit_cast(bf16x8, pw[ks]);
            const LAS unsigned char* vp = buf + vfr + ks * 1024;
            const s16x4 l0 = vtr(vp), h0 = vtr(vp + 512), l1 = vtr(vp + 4096), h1 = vtr(vp + 4096 + 512);
            const bf16x8 v0 = (bf16x8){l0[0], l0[1], l0[2], l0[3], h0[0], h0[1], h0[2], h0[3]}, v1 = (bf16x8){l1[0], l1[1], l1[2], l1[3], h1[0], h1[1], h1[2], h1[3]};
            o0 = __builtin_amdgcn_mfma_f32_32x32x16_bf16(pa, v0, o0, 0, 0, 0);
            o1 = __builtin_amdgcn_mfma_f32_32x32x16_bf16(pa, v1, o1, 0, 0, 0);
            o2 = __builtin_amdgcn_mfma_f32_32x32x16_bf16(pa, ones, o2, 0, 0, 0);
        }
        asm volatile("s_waitcnt vmcnt(0) lgkmcnt(0)" ::: "memory"); __builtin_amdgcn_s_barrier();
    }
#undef ATT_DMA
    LAS bf16* stg = (LAS bf16*)(lds + L_OST + wave * 4096);
#pragma unroll
    for (int r = 0; r < 16; ++r) { const float rl = __builtin_amdgcn_rcpf(o2[r]); const int q = crow(r, hi); stg[q * 64 + r32] = f2bf(o0[r] * rl); stg[q * 64 + 32 + r32] = f2bf(o1[r] * rl); }
    asm volatile("s_waitcnt lgkmcnt(0)" ::: "memory");
#pragma unroll
    for (int i = 0; i < 4; ++i) {
        const int row = i * 8 + (lane >> 3), c8 = lane & 7;
        const u32x4 ov = *(const LAS u32x4*)(stg + row * 64 + c8 * 8);
        const size_t tok = (size_t)(tok0 + 32 * qh + row);
        const u32x4 gv = *(const u32x4*)(A.Gt + tok * GW + h * 64 + c8 * 8);
        u32x4 res;
#pragma unroll
        for (int e = 0; e < 4; ++e) { const float a0 = __uint_as_float(ov[e] << 16) * __uint_as_float(gv[e] << 16), a1 = __uint_as_float(ov[e] & 0xffff0000u) * __uint_as_float(gv[e] & 0xffff0000u); res[e] = cvtpk(a0, a1); }
        *(u32x4*)(A.mix + tok * D + A.colofs + h * 64 + c8 * 8) = res;
    }
}
}
namespace c1 {
typedef short bf16x8 __attribute__((ext_vector_type(8)));
typedef short s16x2 __attribute__((ext_vector_type(2)));
typedef float f32x4 __attribute__((ext_vector_type(4)));
typedef _Float16 f16x2 __attribute__((ext_vector_type(2)));
constexpr int L_HIST = 0, HSTR = 513  , L_CAND = 33024  , L_CTL = L_CAND + 16384  ,
              L_BMS = 50176, BSTR = 129  , L_END = L_BMS + 64 * BSTR * 4;
__device__ __forceinline__ unsigned ord16x2(float a, float b) {
    const f16x2 hv = {(_Float16)a, (_Float16)b};
    const s16x2 x = __builtin_bit_cast(s16x2, hv);
    const s16x2 m = x >> 15;
    const s16x2 y = x ^ (m | (s16x2){(short)0x8000, (short)0x8000});
    return __builtin_bit_cast(unsigned, y);
}
__device__ __forceinline__ void scan_pass(LAS unsigned char* lds, int wave, int lane) {
    const int q = 2 * wave + (lane >> 5), l32 = lane & 31, wb = 496 - 16 * l32;
    LAS unsigned* hist = (LAS unsigned*)(lds + L_HIST) + q * HSTR + wb;
    volatile LAS unsigned* ctl = (volatile LAS unsigned*)(lds + L_CTL) + q * 8;
    unsigned w[16]; unsigned cs = 0;
#pragma unroll
    for (int e = 0; e < 16; ++e) { w[e] = hist[e]; cs += (w[e] & 0xffffu) + (w[e] >> 16); hist[e] = 0u; }
    unsigned P = cs;
#pragma unroll
    for (int o = 1; o < 32; o <<= 1) { const unsigned v = __shfl_up(P, o, 32); if (l32 >= o) P += v; }
    if (P >= 256u && P - cs < 256u) {
        unsigned rem = 256u - (P - cs); int bin = 0; bool done = false;
#pragma unroll
        for (int e = 15; e >= 0; --e) {
            const unsigned chi = w[e] >> 16, clo = w[e] & 0xffffu;
            if (!done) { if (chi >= rem) { bin = 2 * (wb + e) + 1; done = true; } else rem -= chi; }
            if (!done) { if (clo >= rem) { bin = 2 * (wb + e); done = true; } else rem -= clo; }
        }
        ctl[0] = (unsigned)bin; ctl[1] = rem; ctl[2] = 0u;
    }
}

template <int PROBE>
__device__ __forceinline__ void chunk(LAS unsigned char* lds, const bf16* IQ, const bf16* IK, const float* IW, unsigned* bmg, int b, int c, int tid) {
    const int wave0 = __builtin_amdgcn_readfirstlane(tid >> 6);
    const int npairs0 = 2 * (c + 1);
    unsigned* bmrow = bmg + ((size_t)b * S + c * 64) * 128;
    __syncthreads();
    if (c <= 3) { if (PROBE == 0) for (int i = tid; i < 64 * npairs0; i += 512) bmrow[(i / npairs0) * 128 + (i % npairs0)] = 0xffffffffu; __syncthreads(); return; }
    if (PROBE == 0) { for (int i = tid; i < (L_CTL + 512) / 4; i += 512) ((LAS unsigned*)(lds + L_HIST))[i] = 0u; }
    __syncthreads();
    for (int sg = 0; sg < 4; ++sg) {
        int tid_ = tid, wave = wave0, npairs = npairs0; asm volatile("" : "+v"(tid_), "+s"(wave), "+s"(npairs));
        const int lane = tid_ & 63, ql = lane & 15, kg = lane >> 4;
        LAS unsigned* histq = (LAS unsigned*)(lds + (PROBE == 2 ? L_END : L_HIST)) + ql * HSTR;
        volatile LAS unsigned* ctlq = (volatile LAS unsigned*)(lds + L_CTL) + ql * 8;
        LAS unsigned* candq = (LAS unsigned*)(lds + L_CAND) + ql * 256;
        LAS unsigned* bms = (LAS unsigned*)(lds + L_BMS);
        const bf16* ikb = IK + ((size_t)b * S + ql) * 64 + 8 * kg;
        const size_t tokq = (size_t)b * S + c * 64 + 16 * sg + ql;
        unsigned sk[16][4];
        {
            bf16x8 qb[8][2], qc[2]; float cw[8];
            {
                const f32x4 w0 = *(const f32x4*)(IW + tokq * 8), w1 = *(const f32x4*)(IW + tokq * 8 + 4);
#pragma unroll
                for (int h = 0; h < 8; ++h)
#pragma unroll
                    for (int ks = 0; ks < 2; ++ks) qb[h][ks] = *(const bf16x8*)(IQ + tokq * 512 + h * 64 + 32 * ks + 8 * kg);
#pragma unroll
                for (int h = 0; h < 4; ++h) { cw[h] = w0[h] * 0.02209708691207961f; cw[4 + h] = w1[h] * 0.02209708691207961f; }
#pragma unroll
                for (int ks = 0; ks < 2; ++ks) { att::u32x4 pk;
#pragma unroll
                    for (int jp = 0; jp < 4; ++jp) { float a0 = 0.f, a1 = 0.f;
#pragma unroll
                        for (int h = 0; h < 8; ++h) { const unsigned u = __builtin_bit_cast(att::u32x4, qb[h][ks])[jp]; a0 = __builtin_fmaf(cw[h], __uint_as_float(u << 16), a0); a1 = __builtin_fmaf(cw[h], __uint_as_float(u & 0xffff0000u), a1); }
                        asm volatile("" : "+v"(a0), "+v"(a1));
                        pk[jp] = att::cvtpk(a0, a1); }
                    qc[ks] = __builtin_bit_cast(bf16x8, pk); }
            }
            bf16x8 kA[2][2], kB[2][2];
#define C1_LOADK(dst, p_) do { _Pragma("unroll") for (int tt = 0; tt < 2; ++tt) { const bf16* kp_ = ikb + (size_t)(32 * (p_) + 16 * tt) * 64; dst[tt][0] = *(const bf16x8*)kp_; dst[tt][1] = *(const bf16x8*)(kp_ + 32); } } while (0)
#define C1_HADD(v_) do { const unsigned b0_ = ((v_) >> 6) & 1023u, b1_ = (v_) >> 22; \
        __hip_atomic_fetch_add(histq + (b0_ >> 1), 1u << (16 * (b0_ & 1u)), __ATOMIC_RELAXED, __HIP_MEMORY_SCOPE_WORKGROUP); \
        __hip_atomic_fetch_add(histq + (b1_ >> 1), 1u << (16 * (b1_ & 1u)), __ATOMIC_RELAXED, __HIP_MEMORY_SCOPE_WORKGROUP); } while (0)
#define C1_SLOT(i, cur, nxt) do { __builtin_amdgcn_sched_barrier(0); const int p = wave + 8 * (i); \
                if (p < npairs) { \
                    if (p + 8 < npairs && (i) < 15) C1_LOADK(nxt, p + 8); \
                    asm volatile("" ::: "memory"); \
                    _Pragma("unroll") for (int tt = 0; tt < 2; ++tt) { \
                        f32x4 acc = __builtin_amdgcn_mfma_f32_16x16x32_bf16(cur[tt][0], qc[0], (f32x4){0.f, 0.f, 0.f, 0.f}, 0, 0, 0); \
                        acc = __builtin_amdgcn_mfma_f32_16x16x32_bf16(cur[tt][1], qc[1], acc, 0, 0, 0); \
                        _Pragma("unroll") for (int h = 0; h < 8; ++h) { \
                            f32x4 x = __builtin_amdgcn_mfma_f32_16x16x32_bf16(cur[tt][0], qb[h][0], (f32x4){0.f, 0.f, 0.f, 0.f}, 0, 0, 0); \
                            x = __builtin_amdgcn_mfma_f32_16x16x32_bf16(cur[tt][1], qb[h][1], x, 0, 0, 0); \
                            _Pragma("unroll") for (int r = 0; r < 4; ++r) { acc[r] = __builtin_fmaf(cw[h], __builtin_fabsf(x[r]), acc[r]); asm volatile("" : "+v"(acc[r])); } } \
                        sk[i][2 * tt] = ord16x2(acc[0], acc[1]); sk[i][2 * tt + 1] = ord16x2(acc[2], acc[3]); } \
                    if (PROBE != 1) { _Pragma("unroll") for (int j = 0; j < 4; ++j) C1_HADD(sk[i][j]); } \
                    asm volatile("" ::: "memory"); \
                } else { sk[i][0] = 0u; sk[i][1] = 0u; sk[i][2] = 0u; sk[i][3] = 0u; } } while (0)
            if (wave < npairs) C1_LOADK(kA, wave);
            C1_SLOT(0, kA, kB); C1_SLOT(1, kB, kA); C1_SLOT(2, kA, kB); C1_SLOT(3, kB, kA); C1_SLOT(4, kA, kB); C1_SLOT(5, kB, kA); C1_SLOT(6, kA, kB); C1_SLOT(7, kB, kA);
            C1_SLOT(8, kA, kB); C1_SLOT(9, kB, kA); C1_SLOT(10, kA, kB); C1_SLOT(11, kB, kA); C1_SLOT(12, kA, kB); C1_SLOT(13, kB, kA); C1_SLOT(14, kA, kB); C1_SLOT(15, kB, kA);
#undef C1_SLOT
#undef C1_HADD
#undef C1_LOADK
        }
        if (PROBE != 0) { unsigned x = 0; _Pragma("unroll") for (int i = 0; i < 16; ++i) x ^= sk[i][0] ^ sk[i][1] ^ sk[i][2] ^ sk[i][3]; if (x == 0x12345u) bmrow[tid] = x; continue; }
        __syncthreads();
        scan_pass(lds, wave, lane);
        __syncthreads();
        {
            const unsigned b1 = ctlq[0];
#pragma unroll
            for (int i = 0; i < 16; ++i) { __builtin_amdgcn_sched_barrier(0); const int p = wave + 8 * i; if (p < npairs) {
                unsigned word = 0u;
#pragma unroll
                for (int j = 0; j < 4; ++j) { const unsigned v = sk[i][j];
#pragma unroll
                    for (int hf = 0; hf < 2; ++hf) { const unsigned k16 = hf ? (v >> 16) : (v & 0xffffu), bin = k16 >> 6; const int bit = 16 * (j >> 1) + 4 * kg + 2 * (j & 1) + hf;
                        word |= (bin > b1) ? (1u << bit) : 0u;
                        if (bin == b1) { const unsigned s = __hip_atomic_fetch_add((LAS unsigned*)(ctlq + 2), 1u, __ATOMIC_RELAXED, __HIP_MEMORY_SCOPE_WORKGROUP); if (s < 256u) candq[s] = (k16 << 12) | (unsigned)(4095 - (32 * p + bit)); } } }
                word |= __shfl_xor(word, 16); word |= __shfl_xor(word, 32);
                if (kg == 0) bms[(16 * sg + ql) * BSTR + p] = word; } }
        }
        __syncthreads();
        {
            const int q = tid_ >> 5, l32 = tid_ & 31;
            const volatile LAS unsigned* ctl = (const volatile LAS unsigned*)(lds + L_CTL) + q * 8;
            const LAS unsigned* cand = (const LAS unsigned*)(lds + L_CAND) + q * 256;
            const unsigned need = ctl[1]; unsigned m = ctl[2]; m = m > 256u ? 256u : m;
            for (unsigned e = l32; e < m; e += 32) { const unsigned ck = cand[e]; unsigned rank = 0;
                for (unsigned f = 0; f < m; ++f) rank += (cand[f] > ck) ? 1u : 0u;
                if (rank < need) { const unsigned idx = 4095u - (ck & 4095u); __hip_atomic_fetch_or(bms + (16 * sg + q) * BSTR + (idx >> 5), 1u << (idx & 31u), __ATOMIC_RELAXED, __HIP_MEMORY_SCOPE_WORKGROUP); } }
        }
    }
    __syncthreads();
    if (PROBE == 0) for (int i = tid; i < 64 * npairs0; i += 512) { const int q = i / npairs0, w = i % npairs0; bmrow[q * 128 + w] = ((const LAS unsigned*)(lds + L_BMS))[q * BSTR + w]; }
    __syncthreads();
}
}
namespace mixa {
typedef short bf16x8 __attribute__((ext_vector_type(8)));
typedef short s16x4 __attribute__((ext_vector_type(4)));
typedef float f32x16 __attribute__((ext_vector_type(16)));
constexpr int L_VN = 0, L_OST = 65536;
__device__ __forceinline__ void unit(LAS unsigned char* lds, int blk, const bf16* au, const bf16* av, const bf16* ag, const float* lng, const float* lnb, const float* W, const float* bs, bf16* mix, int tid_in) {
    int tid = tid_in; asm volatile("" : "+v"(tid));
    const int lane = tid & 63, wave = __builtin_amdgcn_readfirstlane(tid >> 6), r32 = lane & 31, hi = lane >> 5;
    const size_t row0 = (size_t)blk * 128;
    __syncthreads();
    {
        const f32x4 gg = *(const f32x4*)(lng + lane * 4), bb = *(const f32x4*)(lnb + lane * 4);
        const unsigned wofs = L_VN + (lane >> 4) * 16384 + ((lane >> 3) & 1) * 8192 + (lane & 7) * 8;
        unsigned long long raw[16];
#pragma unroll
        for (int rr = 0; rr < 16; ++rr) raw[rr] = *(const unsigned long long*)(av + (row0 + wave * 16 + rr) * GW + lane * 4);
#pragma unroll
        for (int rr = 0; rr < 16; ++rr) { const int row = wave * 16 + rr;
            f32x4 v; v[0] = __uint_as_float((unsigned)raw[rr] << 16); v[1] = __uint_as_float((unsigned)raw[rr] & 0xffff0000u); v[2] = __uint_as_float((unsigned)(raw[rr] >> 32) << 16); v[3] = __uint_as_float((unsigned)(raw[rr] >> 32) & 0xffff0000u);
            const float mean = wave_sum((v[0] + v[1]) + (v[2] + v[3])) * (1.f / GW);
            v = v - mean;
            const float rstd = rsqrtf(wave_sum((v[0] * v[0] + v[1] * v[1]) + (v[2] * v[2] + v[3] * v[3])) * (1.f / GW) + LN_EPS);
            v = v * rstd * gg + bb;
            *(LAS unsigned long long*)(lds + wofs + row * 64) = (unsigned long long)att::cvtpk(v[0], v[1]) | ((unsigned long long)att::cvtpk(v[2], v[3]) << 32); }
    }
    __syncthreads();
    const int g = wave >> 1;
    const LAS unsigned char* vb = lds + L_VN + g * 16384 + ((lane >> 4) & 1) * 32 + (lane & 3) * 8 + (8 * hi + ((lane & 15) >> 2)) * 64;
    LAS bf16* stg = (LAS bf16*)(lds + L_OST + wave * 4096);
#pragma unroll 1
    for (int tt = 0; tt < 2; ++tt) {
        const int ib = (wave & 1) ? (tt ? 2 : 1) : (tt ? 3 : 0);
        const float* wrow = W + ((size_t)g * 128 + 32 * ib + r32) * 128 + 8 * hi;
        f32x4 wf[8][2];
#pragma unroll
        for (int ks = 0; ks < 8; ++ks) if (ks < 4 || ib >= 2) { wf[ks][0] = *(const f32x4*)(wrow + 16 * ks); wf[ks][1] = *(const f32x4*)(wrow + 16 * ks + 4); }
        f32x16 o0 = {}, o1 = {};
#pragma unroll
        for (int ks = 0; ks < 8; ++ks) if (ks < 4 || ib >= 2) {
            const att::u32x4 aw = {att::cvtpk(wf[ks][0][0], wf[ks][0][1]), att::cvtpk(wf[ks][0][2], wf[ks][0][3]), att::cvtpk(wf[ks][1][0], wf[ks][1][1]), att::cvtpk(wf[ks][1][2], wf[ks][1][3])};
            const bf16x8 a = __builtin_bit_cast(bf16x8, aw);
            const LAS unsigned char* p = vb + ks * 1024;
            const s16x4 l0 = att::vtr(p), h0 = att::vtr(p + 256), l1 = att::vtr(p + 8192), h1 = att::vtr(p + 8192 + 256);
            const bf16x8 v0 = (bf16x8){l0[0], l0[1], l0[2], l0[3], h0[0], h0[1], h0[2], h0[3]}, v1 = (bf16x8){l1[0], l1[1], l1[2], l1[3], h1[0], h1[1], h1[2], h1[3]};
            o0 = __builtin_amdgcn_mfma_f32_32x32x16_bf16(a, v0, o0, 0, 0, 0);
            o1 = __builtin_amdgcn_mfma_f32_32x32x16_bf16(a, v1, o1, 0, 0, 0);
        }
#pragma unroll
        for (int gq = 0; gq < 4; ++gq) { const f32x4 bsv = *(const f32x4*)(bs + g * 128 + 32 * ib + 8 * gq + 4 * hi);
#pragma unroll
            for (int j = 0; j < 4; ++j) { const int q = 8 * gq + 4 * hi + j; stg[q * 64 + r32] = f2bf(o0[4 * gq + j] + bsv[j]); stg[q * 64 + 32 + r32] = f2bf(o1[4 * gq + j] + bsv[j]); } }
        asm volatile("s_waitcnt lgkmcnt(0)" ::: "memory");
#pragma unroll
        for (int i = 0; i < 4; ++i) {
            const int row = i * 8 + (lane >> 3), c8 = lane & 7;
            const att::u32x4 ov = *(const LAS att::u32x4*)(stg + row * 64 + c8 * 8);
            const size_t tok = row0 + 32 * ib + row;
            const att::u32x4 uv = *(const att::u32x4*)(au + tok * GW + g * 64 + c8 * 8), gv = *(const att::u32x4*)(ag + tok * GW + g * 64 + c8 * 8);
            att::u32x4 res;
#pragma unroll
            for (int e = 0; e < 4; ++e) { const float a0 = __uint_as_float(ov[e] << 16) * __uint_as_float(uv[e] << 16) * __uint_as_float(gv[e] << 16), a1 = __uint_as_float(ov[e] & 0xffff0000u) * __uint_as_float(uv[e] & 0xffff0000u) * __uint_as_float(gv[e] & 0xffff0000u); res[e] = att::cvtpk(a0, a1); }
            *(att::u32x4*)(mix + tok * D + g * 64 + c8 * 8) = res;
        }
        asm volatile("s_waitcnt lgkmcnt(0)" ::: "memory");
    }
}
}
constexpr int RING_OFF = 0, RING_BYTES = 131072;
constexpr int LDSCTL_OFF = 147456 - 1024, MISC_OFF = LDSCTL_OFF + 320;
constexpr int SCR_OFF = 138240;
constexpr int LDS_BYTES = 147456;
constexpr int NWAVES = 8;

struct Args { const float* in[17]; float* out; unsigned char* ws; };

__device__ __forceinline__ void transpose_item(const float* W, int N, bf16* WT, bool perm, LAS float* scr, int item, int lane) {
    const int nblk = (N + 31) / 32, kb = item / nblk, nb = item % nblk, k0 = 64 * kb, n0 = 32 * nb;
    const bool nok = n0 + (lane & 31) < N;
#pragma unroll 8
    for (int i = 0; i < 32; ++i) { const int kk = 2 * i + (lane >> 5); scr[kk * 33 + (lane & 31)] = nok ? W[(size_t)(k0 + kk) * N + n0 + (lane & 31)] : 0.f; }
    asm volatile("s_waitcnt lgkmcnt(0)" ::: "memory");
    const int c = lane & 7;
#pragma unroll
    for (int j = 0; j < 4; ++j) { const int n = (lane >> 3) + 8 * j; const LAS float* s = scr + (8 * c) * 33 + n;
        if (n0 + n < N) {
            v4u o; o.x = pk2(s[0 * 33], s[1 * 33]); o.y = pk2(s[2 * 33], s[3 * 33]); o.z = pk2(s[4 * 33], s[5 * 33]); o.w = pk2(s[6 * 33], s[7 * 33]);
            const int drow = perm ? perm_col(n0 + n) : (n0 + n);
            *(GAS v4u*)(WT + (size_t)drow * 1024 + k0 + 8 * c) = o; } }
    asm volatile("s_waitcnt lgkmcnt(0)" ::: "memory");
}
__device__ __forceinline__ void ln_row(const float* in, float* out, bf16* outb, const float* g, const float* b, int lane) {
    const f32x4* xr = (const f32x4*)in + lane;
    f32x4 v[4]; float s = 0.f;
#pragma unroll
    for (int j = 0; j < 4; ++j) { v[j] = xr[64 * j]; s += (v[j].x + v[j].y) + (v[j].z + v[j].w); }
    const float mean = wave_sum(s) * (1.f / D); float s2 = 0.f;
#pragma unroll
    for (int j = 0; j < 4; ++j) { v[j] = v[j] - mean; s2 += (v[j].x * v[j].x + v[j].y * v[j].y) + (v[j].z * v[j].z + v[j].w * v[j].w); }
    const float rstd = rsqrtf(wave_sum(s2) * (1.f / D) + LN_EPS);
#pragma unroll
    for (int j = 0; j < 4; ++j) {
        const int c = 4 * (lane + 64 * j);
        const f32x4 o = v[j] * rstd * *(const f32x4*)(g + c) + *(const f32x4*)(b + c);
        *(f32x4*)(out + c) = o;
        *(unsigned long long*)(outb + c) = (unsigned long long)pk2(o.x, o.y) | ((unsigned long long)pk2(o.z, o.w) << 32);
    }
}
__device__ __forceinline__ void memkv_tile(const float* A, const float* W, bf16* km, bf16* vm, int tm, int tn, LAS float* As, LAS float* Bs, int tid) {
    const int tx = tid & 15, ty = tid >> 4, m0 = tm * 128, n0 = tn * 64;
    float acc[4][4];
#pragma unroll
    for (int i = 0; i < 4; ++i)
#pragma unroll
        for (int j = 0; j < 4; ++j) acc[i][j] = 0.f;
    for (int k0 = 0; k0 < D; k0 += 16) {
#pragma unroll
        for (int i = 0; i < 4; ++i) { const int e = tid + 512 * i, r = e >> 4, kk = e & 15; As[kk * 129 + r] = A[(size_t)(m0 + r) * D + k0 + kk]; }
#pragma unroll
        for (int i = 0; i < 2; ++i) { const int e = tid + 512 * i, kk = e >> 6, c = e & 63; Bs[kk * 65 + c] = W[(size_t)(k0 + kk) * 512 + n0 + c]; }
        __syncthreads();
#pragma unroll
        for (int kk = 0; kk < 16; ++kk) {
            float a[4], b[4];
#pragma unroll
            for (int i = 0; i < 4; ++i) { a[i] = As[kk * 129 + ty * 4 + i]; b[i] = Bs[kk * 65 + tx * 4 + i]; }
#pragma unroll
            for (int i = 0; i < 4; ++i)
#pragma unroll
                for (int j = 0; j < 4; ++j) acc[i][j] += a[i] * b[j];
        }
        __syncthreads();
    }
#pragma unroll
    for (int i = 0; i < 4; ++i)
#pragma unroll
        for (int j = 0; j < 4; ++j) { const int row = m0 + ty * 4 + i, col = n0 + tx * 4 + j;
            if (col < 256) km[(size_t)row * 256 + col] = f2bf(acc[i][j]); else vm[(size_t)row * 256 + col - 256] = f2bf(acc[i][j]); }
}

__device__ __forceinline__ void mixer_a_unit(int blk, const bf16* au, const bf16* av, const bf16* ag, const float* lng, const float* lnb, const float* ws_, const float* bs, bf16* mix, LAS float* vt, int tid) {
    const int wave = tid >> 6, lane = tid & 63;
    const size_t row0 = (size_t)blk * 128;
    for (int r = wave; r < 128; r += NWAVES) {
        const bf16* p = av + (row0 + r) * GW + lane * 4;
        float v[4]; float s = 0.f;
#pragma unroll
        for (int j = 0; j < 4; ++j) { v[j] = bf2f(p[j]); s += v[j]; }
        const float mean = wave_sum(s) * (1.f / GW); float s2 = 0.f;
#pragma unroll
        for (int j = 0; j < 4; ++j) { v[j] -= mean; s2 += v[j] * v[j]; }
        const float rstd = rsqrtf(wave_sum(s2) * (1.f / GW) + LN_EPS);
#pragma unroll
        for (int j = 0; j < 4; ++j) vt[r * 256 + lane * 4 + j] = bf2f(f2bf(v[j] * rstd * lng[lane * 4 + j] + lnb[lane * 4 + j]));
    }
    __syncthreads();
    const int ch = tid & 255, g = ch >> 6;
    for (int i = tid >> 8; i < 128; i += 2) {
        const float* wr = ws_ + ((size_t)g * 128 + i) * 128;
        const int jmax = i < 64 ? 64 : 128;
        float acc = 0.f;
        for (int j = 0; j < jmax; ++j) acc += wr[j] * vt[j * 256 + ch];
        acc += bs[g * 128 + i];
        const size_t idx = (row0 + i) * GW + ch;
        mix[(row0 + i) * D + ch] = f2bf(bf2f(au[idx]) * acc * bf2f(ag[idx]));
    }
    __syncthreads();
}
template <int MODE>
__device__ __forceinline__ void attn_wave(int token, int h, const bf16* Q, const bf16* K, const bf16* V, const bf16* G, bf16* mix, int colofs, const float* tbl,
                                          LAS float* sc, LAS float* qs, const LAS unsigned* keys, unsigned Tv, int Ti, int lane, float qscale = 1.f, const unsigned* bmg = nullptr) {
    const int b = token / S, pos = token % S, c = pos >> 6;
    int k0, k1; size_t kbase;
    if (MODE == 0) { k0 = (c >= 8 ? c - 8 : 0) * 64; k1 = (c + 1) * 64; kbase = (size_t)b * S; }
    else if (MODE == 1 || MODE == 3) { k0 = 0; k1 = (c + 1) * 64; kbase = (size_t)b * S; }
    else { k0 = 0; k1 = NMEM; kbase = (size_t)b * NMEM; }
    qs[lane] = bf2f(Q[(size_t)token * GW + h * 64 + lane]);
    asm volatile("s_waitcnt lgkmcnt(0)" ::: "memory");
    float mx = -INFINITY;
    for (int key = k0 + lane; key < k1; key += 64) {
        const bf16* kr = K + (kbase + key) * GW + h * 64;
        float s = 0.f;
#pragma unroll 8
        for (int d = 0; d < 64; ++d) s += qs[d] * bf2f(kr[d]);
        s *= qscale;
        if (MODE != 2) { int dd = pos - key; dd = dd < -128 ? -128 : (dd > 128 ? 128 : dd); s += tbl[h * 257 + dd + 128]; }
        if (MODE == 1) { const unsigned kv = keys[key]; if (!(kv > Tv || (kv == Tv && key <= Ti))) s = -INFINITY; }
        if (MODE == 3) { if (!((bmg[(size_t)token * 128 + (key >> 5)] >> (key & 31)) & 1u)) s = -INFINITY; }
        sc[key - k0] = s; mx = fmaxf(mx, s);
    }
    mx = wave_max(mx);
    float sum = 0.f;
    for (int key = k0 + lane; key < k1; key += 64) { const float p = __expf(sc[key - k0] - mx); sc[key - k0] = p; sum += p; }
    sum = wave_sum(sum);
    asm volatile("s_waitcnt lgkmcnt(0)" ::: "memory");
    float o = 0.f;
    for (int key = k0; key < k1; ++key) { const float p = sc[key - k0]; if (p != 0.f) o += p * bf2f(V[(kbase + key) * GW + h * 64 + lane]); }
    o /= sum;
    mix[(size_t)token * D + colofs + h * 64 + lane] = f2bf(o * bf2f(G[(size_t)token * GW + h * 64 + lane]));
    asm volatile("s_waitcnt lgkmcnt(0)" ::: "memory");
}
__device__ __forceinline__ int block_sum_i(int v, volatile LAS int* red, int tid) {
#pragma unroll
    for (int o = 1; o < 64; o <<= 1) v += __shfl_xor(v, o);
    __syncthreads();
    if ((tid & 63) == 0) red[tid >> 6] = v;
    __syncthreads();
    int s = 0;
#pragma unroll
    for (int w = 0; w < NWAVES; ++w) s += red[w];
    return s;
}
__device__ __forceinline__ void mixer_c_token(int token, const bf16* IQ, const bf16* IK, const float* IW, const bf16* Q, const bf16* K, const bf16* V, const bf16* G, bf16* mix, const float* tbl,
                                              LAS unsigned char* lds, int tid, float qscale = 1.f, const unsigned* bmg = nullptr, float* dacc = nullptr) {
    LAS unsigned* keys = (LAS unsigned*)(lds + RING_OFF);
    LAS float* qh = (LAS float*)(lds + SCR_OFF + 4096);
    LAS float* wq = (LAS float*)(lds + SCR_OFF + 4096 + 2048);
    volatile LAS int* red = (volatile LAS int*)(lds + SCR_OFF + 4096 + 2048 + 64);
    const int wave = tid >> 6, lane = tid & 63;
    const int b = token / S, pos = token % S, c = pos >> 6, n = (c + 1) * 64;
    qh[tid] = bf2f(IQ[(size_t)token * 512 + tid]);
    if (tid < 8) wq[tid] = IW[(size_t)token * 8 + tid] * 0.35355339059327373f;
    __syncthreads();
    for (int key = tid; key < n; key += 512) {
        const bf16* kr = IK + ((size_t)b * S + key) * 64;
        float score = 0.f;
        for (int h = 0; h < 8; ++h) {
            float s = 0.f;
#pragma unroll 8
            for (int d = 0; d < 64; ++d) s += qh[h * 64 + d] * bf2f(kr[d]);
            s *= 0.125f;
            score += fmaxf(s, 0.f) * wq[h];
        }
        const unsigned u = __float_as_uint(score);
        keys[key] = (u & 0x80000000u) ? ~u : (u | 0x80000000u);
    }
    __syncthreads();
    unsigned Tv = 0u; int Ti = 4095;
    if (n > 256) {
        unsigned prefix = 0u;
        for (int bit = 31; bit >= 0; --bit) {
            const unsigned cand = prefix | (1u << bit);
            int cnt = 0;
            for (int key = tid; key < n; key += 512) cnt += (keys[key] >= cand) ? 1 : 0;
            cnt = block_sum_i(cnt, red, tid);
            if (cnt >= 256) prefix = cand;
        }
        Tv = prefix;
        int cgt = 0;
        for (int key = tid; key < n; key += 512) cgt += (keys[key] > Tv) ? 1 : 0;
        cgt = block_sum_i(cgt, red, tid);
        const int r = 256 - cgt;
        int I = 0;
        for (int bit = 11; bit >= 0; --bit) {
            const int cand = I | (1 << bit);
            int cnt = 0;
            for (int key = tid; key < n; key += 512) cnt += (keys[key] == Tv && key < cand) ? 1 : 0;
            cnt = block_sum_i(cnt, red, tid);
            if (cnt < r) I = cand;
        }
        Ti = I;
    }
    if (bmg) {
        if (tid < 128) { unsigned w = 0u; const int lo = tid * 32;
            if (lo < n) { if (n <= 256) w = 0xffffffffu; else for (int j = 0; j < 32; ++j) { const unsigned kv = keys[lo + j]; if (kv > Tv || (kv == Tv && lo + j <= Ti)) w |= 1u << j; } }
            const unsigned o = lo < n ? bmg[(size_t)token * 128 + tid] : 0u;
            float dx = (float)__popc(w ^ o), dr = (float)__popc(w); dx = wave_sum(dx); dr = wave_sum(dr);
            if (lane == 0) { atomicAdd(dacc + 8, dx); atomicAdd(dacc + 9, dr); } }
        if (wave < 4) attn_wave<3>(token, wave, Q, K, V, G, mix, 512, tbl, (LAS float*)(lds + RING_OFF + 16384 + wave * 16384), (LAS float*)(lds + SCR_OFF + wave * 256), keys, Tv, Ti, lane, qscale, bmg);
    } else if (wave < 4) attn_wave<1>(token, wave, Q, K, V, G, mix, 512, tbl, (LAS float*)(lds + RING_OFF + 16384 + wave * 16384), (LAS float*)(lds + SCR_OFF + wave * 256), keys, Tv, Ti, lane, qscale);
    __syncthreads();
}

#ifndef REP_A
#define REP_A 1
#endif
#ifndef REP_C1
#define REP_C1 1
#endif
#ifndef REP_C2
#define REP_C2 1
#endif
#ifndef REP_B
#define REP_B 1
#endif
#ifndef REP_M
#define REP_M 1
#endif
#ifndef REP_C
#define REP_C 1
#endif
template <int OFF> __device__ __forceinline__ unsigned long long karg_u64() {
    const __attribute__((address_space(4))) char* k = (const __attribute__((address_space(4))) char*)__builtin_amdgcn_kernarg_segment_ptr();
    unsigned long long v;
    asm volatile("s_load_dwordx2 %0, %1, %2\n\ts_waitcnt lgkmcnt(0)" : "=s"(v) : "s"(k), "i"(OFF) : "memory");
    return v;
}
#define IN_PTR(i) ((const float*)karg_u64<8 * (i)>())
#define OUT_PTR() ((float*)karg_u64<8 * 17>())
#define WS_PTR() ((unsigned char*)karg_u64<8 * 18>())
#define GRP(g) ((bf16*)(WS_PTR() + WS_P13) + (size_t)(g) * T * GW)
#define GRID_BAR() do { XcdBarrier b_; b_.bar = (unsigned*)((gu32*)(WS_PTR() + WS_CTL) + CW_BAR); b_.x = xb_xcc_id(); b_.st = (volatile LAS unsigned*)((LAS unsigned char*)lds_raw + MISC_OFF) + 8; xcd_barrier(b_); } while (0)

__global__ void __launch_bounds__(NWAVES * 64, 2) mk_fwd(Args args) {
    extern __shared__ __attribute__((aligned(16))) unsigned char lds_raw[];
    {
        LAS unsigned char* lds = (LAS unsigned char*)lds_raw;
        for (int u = threadIdx.x; u < (LDS_BYTES - LDSCTL_OFF) / 4; u += NWAVES * 64) ((LAS unsigned*)(lds + LDSCTL_OFF))[u] = 0u;
        __syncthreads();
        (void)xcd_barrier_post((unsigned*)((gu32*)(WS_PTR() + WS_CTL) + CW_BAR), (volatile LAS unsigned*)(lds + MISC_OFF) + 8);
    }
    {
        LAS unsigned char* lds = (LAS unsigned char*)lds_raw;
        const int tid = threadIdx.x, lane = tid & 63, wave = __builtin_amdgcn_readfirstlane(tid >> 6);
        const int G = gridDim.x, bx = blockIdx.x, vcu = (G % 8 == 0) ? (bx % 8) * (G / 8) + bx / 8 : bx;
        const int gw = vcu * NWAVES + wave, NGW = G * NWAVES;
        unsigned char* ws = WS_PTR();
        const float* w_in = IN_PTR(4); const float* w_out = IN_PTR(13);
        bf16* WIN = (bf16*)(ws + WS_WIN); bf16* WOUT = (bf16*)(ws + WS_WOUT);
        float* tbl = (float*)(ws + WS_TBL); float* bperm = (float*)(ws + WS_TBL + 65536);
        LAS float* scr = (LAS float*)(lds + RING_OFF + wave * 16384);
        constexpr int I_IN = 16 * 123, I_OUT = 16 * 32;
        for (int it = gw; it < 2 * I_IN + 2 * I_OUT; it += NGW) {
            int r = it;
            if (r < 2 * I_IN) { const int l = r / I_IN; transpose_item(w_in + (size_t)l * D * DIN, DIN, WIN + (size_t)l * DINP * D, true, scr, r % I_IN, lane); }
            else { r -= 2 * I_IN; const int l = r / I_OUT; transpose_item(w_out + (size_t)l * D * D, D, WOUT + (size_t)l * D * D, false, scr, r % I_OUT, lane); }
        }
        { const float* b_in = IN_PTR(5);
          for (int i = bx * 512 + tid; i < 2 * DINP; i += G * 512) { const int l = i / DINP, p = i % DINP; int col = -1;
              if (p < 3328) col = p; else if (p < 3584) col = 3400 + (p - 3328); else if (p < 3840) col = 3656 + (p - 3584); else if (p < 3904) col = 3328 + (p - 3840); else if (p < 3912) col = 3392 + (p - 3904);
              bperm[i] = col >= 0 ? b_in[l * DIN + col] : 0.f; } }
        { const float* t5 = IN_PTR(11);
          for (int i = bx * 512 + tid; i < 4 * 257; i += G * 512) {
            const int h = i / 257, d = i % 257 - 128, rel = -d, n = rel < 0 ? -rel : rel;
            int bucket = rel > 0 ? 16 : 0;
            if (n < 8) bucket += n; else { int large = 8 + (31 - __clz(n * n)) - 6; if (large > 15) large = 15; bucket += large; }
            tbl[i] = t5[bucket * 4 + h];
          } }
        { const float* x = IN_PTR(0); float* out = OUT_PTR(); bf16* HB = (bf16*)(ws + WS_HB); const float* g = IN_PTR(2); const float* b = IN_PTR(3);
          for (int m = gw; m < T; m += NGW) ln_row(x + (size_t)m * D, out + (size_t)m * D, HB + (size_t)m * D, g, b, lane); }
        {
            const float* mem = IN_PTR(1); const float* w_mem = IN_PTR(12);
            bf16* MEMB = (bf16*)(ws + WS_MEMB); bf16* WMT = (bf16*)(ws + WS_WMT);
            for (int i = bx * 512 + tid; i < NB * NMEM * D / 8; i += G * 512) { const f32x4 a = *(const f32x4*)(mem + (size_t)i * 8), b2 = *(const f32x4*)(mem + (size_t)i * 8 + 4);
                v4u o; o.x = pk2(a.x, a.y); o.y = pk2(a.z, a.w); o.z = pk2(b2.x, b2.y); o.w = pk2(b2.z, b2.w); *(v4u*)(MEMB + (size_t)i * 8) = o; }
            constexpr int I_M = 16 * 16;
            for (int it = gw; it < 2 * I_M; it += NGW) { const int l = it / I_M; transpose_item(w_mem + (size_t)l * D * 512, 512, WMT + (size_t)l * 512 * D, false, scr, it % I_M, lane); }
        }
    }
    GRID_BAR();
    {
        unsigned char* ws = WS_PTR();
        pg8::Gemm g{(const bf16*)(ws + WS_MEMB), (const bf16*)(ws + WS_WMT), NB * NMEM, 1024, D}; pg8::StaticOrder SO; SO.init(NB * NMEM, 1024, gridDim.x, blockIdx.x);
        pg8::EpiKV E{(bf16*)(ws + WS_KM), (bf16*)(ws + WS_VM)};
        pg8::gemm_phase<pg8::EpiKV, pg8::StaticOrder, true, true>((LAS unsigned char*)lds_raw + RING_OFF, g, SO, E);
    }

    for (int l = 0; l < 2; ++l) {
#ifndef NO_P1
        {
            unsigned char* ws = WS_PTR();
            pg8::Gemm g{(const bf16*)(ws + WS_HB), (const bf16*)(ws + WS_WIN) + (size_t)l * DINP * D, T, DINP, D}; pg8::StaticOrder SO; SO.init(T, DINP, gridDim.x, blockIdx.x);
            pg8::EpiRoute E{(bf16*)(ws + WS_P13), (bf16*)(ws + WS_IQ), (bf16*)(ws + WS_IK), (float*)(ws + WS_IW), (const float*)(ws + WS_TBL + 65536) + l * DINP};
            pg8::gemm_phase<pg8::EpiRoute, pg8::StaticOrder, true, true>((LAS unsigned char*)lds_raw + RING_OFF, g, SO, E);
        }
#endif
        GRID_BAR();
#ifndef NO_P2
        {
            LAS unsigned char* lds = (LAS unsigned char*)lds_raw;
            int tid_ = threadIdx.x, G_ = gridDim.x, bx_ = blockIdx.x; asm volatile("" : "+v"(tid_), "+s"(G_), "+s"(bx_));
            const int tid = tid_, lane = tid & 63, wave = __builtin_amdgcn_readfirstlane(tid >> 6);
            const int G = G_, bx = bx_, vcu = (G % 8 == 0) ? (bx % 8) * (G / 8) + bx / 8 : bx;
            const int gw = vcu * NWAVES + wave, NGW = G * NWAVES;
            unsigned char* ws = WS_PTR();
            bf16* MIX = (bf16*)(ws + WS_MIX);
            const bf16* KM = (const bf16*)(ws + WS_KM) + (size_t)l * NB * NMEM * 256; const bf16* VM = (const bf16*)(ws + WS_VM) + (size_t)l * NB * NMEM * 256;
            for (int rep_ = 0; rep_ < REP_A; ++rep_)
            for (int blk = vcu; blk < T / 128; blk += G)
                mixa::unit(lds, blk, GRP(G_AU), GRP(G_AV), GRP(G_AG), IN_PTR(6) + l * GW, IN_PTR(7) + l * GW, IN_PTR(8) + (size_t)l * 4 * 128 * 128, IN_PTR(9) + l * 4 * 128, MIX, tid);
            __syncthreads();
            for (int rep_ = 0; rep_ < REP_B; ++rep_)
            {
                att::fill_bias(lds, IN_PTR(10) + (size_t)l * 4 * 257, tid);
                att::Cfg cfg{GRP(G_BQ), GRP(G_BK), GRP(G_BV), GRP(G_BG), MIX, 256};
                for (int u = vcu; u < NB * 64; u += G) { const int b = u >> 6, c = u & 63, kt0 = c >= 8 ? c - 8 : 0;
                    att::unit<0>(lds, cfg, b * S + c * 64, (size_t)b * S + kt0 * 64, c - kt0 + 1, (c - kt0) * 64, nullptr, tid); }
            }
            for (int rep_ = 0; rep_ < REP_M; ++rep_)
            {
                att::Cfg cfg{GRP(G_MQ), KM, VM, GRP(G_MG), MIX, 768};
                for (int u = vcu; u < NB * 64; u += G) { const int b = u >> 6, c = u & 63;
                    att::unit<2>(lds, cfg, b * S + c * 64, (size_t)b * NMEM, NMEM / 64, 0, nullptr, tid); }
            }
#ifdef DEBUG_CMP
            if (l == 0) {
                __syncthreads();
                bf16* MIXR = (bf16*)(ws + 422 * MiB);
                LAS float* sc = (LAS float*)(lds + RING_OFF + wave * 16384); LAS float* qs = (LAS float*)(lds + SCR_OFF + wave * 256);
                const float* brel = IN_PTR(10);
                for (int it = gw; it < T * 4; it += NGW) attn_wave<0>(it >> 2, it & 3, GRP(G_BQ), GRP(G_BK), GRP(G_BV), GRP(G_BG), MIXR, 256, brel, sc, qs, nullptr, 0u, 0, lane, 0.6931471805599453f);
                for (int it = gw; it < T * 4; it += NGW) attn_wave<2>(it >> 2, it & 3, GRP(G_MQ), KM, VM, GRP(G_MG), MIXR, 768, nullptr, sc, qs, nullptr, 0u, 0, lane, 0.6931471805599453f);
            }
#endif
            __syncthreads();
            for (int rep_ = 0; rep_ < REP_C; ++rep_)
            {
                att::fill_bias(lds, (const float*)(ws + WS_TBL), tid);
                att::Cfg cfg{GRP(G_CQ), GRP(G_CK), GRP(G_CV), GRP(G_CG), MIX, 512};
                for (int u = vcu; u < NB * 32; u += G) { const int b = u >> 5, j = u & 31;
                    for (int side = 0; side < 2; ++side) { const int c = side ? 63 - j : j;
#ifdef PROBE_C1
                        c1::chunk<PROBE_C1>(lds, (const bf16*)(ws + WS_IQ), (const bf16*)(ws + WS_IK), (const float*)(ws + WS_IW), (unsigned*)(ws + WS_BM), b, c, tid);
#endif
                        c1::chunk<0>(lds, (const bf16*)(ws + WS_IQ), (const bf16*)(ws + WS_IK), (const float*)(ws + WS_IW), (unsigned*)(ws + WS_BM), b, c, tid);
                        for (int r2_ = 0; r2_ < REP_C2; ++r2_)
                        att::unit<1>(lds, cfg, b * S + c * 64, (size_t)b * S, c + 1, c * 64, (const unsigned*)(ws + WS_BM), tid); } }
            }
        }
#endif
        GRID_BAR();
#ifdef DEBUG_CMP
        if (l == 0) {
            int tid_ = threadIdx.x, G_ = gridDim.x, bx_ = blockIdx.x; asm volatile("" : "+v"(tid_), "+s"(G_), "+s"(bx_));
            const int tid = tid_, lane = tid & 63, wave = __builtin_amdgcn_readfirstlane(tid >> 6);
            const int G = G_, bx = bx_, vcu = (G % 8 == 0) ? (bx % 8) * (G / 8) + bx / 8 : bx;
            const int gw = vcu * NWAVES + wave, NGW = G * NWAVES;
            unsigned char* ws = WS_PTR(); const bf16* MIX = (const bf16*)(ws + WS_MIX); bf16* MIXR = (bf16*)(ws + 422 * MiB);
            {   LAS unsigned char* lds = (LAS unsigned char*)lds_raw;
                for (int token = bx; token < T; token += G) mixer_c_token(token, (const bf16*)(ws + WS_IQ), (const bf16*)(ws + WS_IK), (const float*)(ws + WS_IW), GRP(G_CQ), GRP(G_CK), GRP(G_CV), GRP(G_CG), MIXR, (const float*)(ws + WS_TBL), lds, tid,
                                                                          0.6931471805599453f, (const unsigned*)(ws + WS_BM), (float*)(ws + WS_CTL) + 2048); }
            GRID_BAR();
                float* acc = (float*)(ws + WS_CTL) + 2048;
                for (int seg = 1; seg < 4; ++seg) {
                    float sd = 0.f, sr = 0.f;
                    for (int m = gw; m < T; m += NGW) for (int j = 0; j < 4; ++j) { const size_t idx = (size_t)m * D + seg * 256 + lane * 4 + j; const float a = bf2f(MIX[idx]), r = bf2f(MIXR[idx]); sd += (a - r) * (a - r); sr += r * r; }
                    sd = wave_sum(sd); sr = wave_sum(sr);
                    if (lane == 0) { atomicAdd(acc + 2 * seg, sd); atomicAdd(acc + 2 * seg + 1, sr); }
                }
        }
#endif
#ifndef NO_P3
        {
            unsigned char* ws = WS_PTR();
            pg8::Gemm g{(const bf16*)(ws + WS_MIX), (const bf16*)(ws + WS_WOUT) + (size_t)l * D * D, T, D, D}; pg8::StaticOrder SO; SO.init(T, D, gridDim.x, blockIdx.x);
            pg8::EpiResid E{OUT_PTR(), IN_PTR(14) + l * D};
            pg8::gemm_phase<pg8::EpiResid, pg8::StaticOrder, true, true>((LAS unsigned char*)lds_raw + RING_OFF, g, SO, E);
        }
#endif
        GRID_BAR();
        {
            int tid_ = threadIdx.x, G_ = gridDim.x, bx_ = blockIdx.x; asm volatile("" : "+v"(tid_), "+s"(G_), "+s"(bx_));
            const int tid = tid_, lane = tid & 63, wave = __builtin_amdgcn_readfirstlane(tid >> 6);
            const int G = G_, bx = bx_, vcu = (G % 8 == 0) ? (bx % 8) * (G / 8) + bx / 8 : bx;
            const int gw = vcu * NWAVES + wave, NGW = G * NWAVES;
            float* out = OUT_PTR(); bf16* HB = (bf16*)(WS_PTR() + WS_HB); const float* g = IN_PTR(15) + l * D; const float* b = IN_PTR(16) + l * D;
            for (int m = gw; m < T; m += NGW) ln_row(out + (size_t)m * D, out + (size_t)m * D, HB + (size_t)m * D, g, b, lane);
        }
        if (l == 0) GRID_BAR();
    }
#ifdef DEBUG_CMP
    GRID_BAR();
    if (blockIdx.x == 0 && threadIdx.x < 5) { const float* acc = (const float*)(WS_PTR() + WS_CTL) + 2048; const int seg = threadIdx.x; const float sd = acc[2 * seg], sr = acc[2 * seg + 1];
        if (sr > 0.f) OUT_PTR()[seg] = 1000.f * sqrtf(sd / sr); }
#endif
}

extern "C" void kernel_launch(void* const* d_in, const int* in_sizes, int n_in, void* d_out, int out_size, void* d_ws, size_t ws_size, hipStream_t stream) {
    static int grid = 0;
    if (grid == 0) {
        if (n_in != 17 || out_size != T * D || ws_size < WS_END) { fprintf(stderr, "kernel_launch: unexpected n_in %d / out_size %d / ws_size %zu; nothing launched\n", n_in, out_size, ws_size); grid = -1; return; }
        int dev = 0, cus = 0, per_cu = 0;
        if (hipGetDevice(&dev) != hipSuccess || hipDeviceGetAttribute(&cus, hipDeviceAttributeMultiprocessorCount, dev) != hipSuccess) { grid = -1; return; }
        if (hipFuncSetAttribute((const void*)mk_fwd, hipFuncAttributeMaxDynamicSharedMemorySize, LDS_BYTES) != hipSuccess) { fprintf(stderr, "kernel_launch: hipFuncSetAttribute failed\n"); grid = -1; return; }
        if (hipOccupancyMaxActiveBlocksPerMultiprocessor(&per_cu, (const void*)mk_fwd, NWAVES * 64, LDS_BYTES) != hipSuccess || per_cu < 1) { fprintf(stderr, "kernel_launch: occupancy query says %d blocks per CU; nothing launched\n", per_cu); (void)hipGetLastError(); grid = -1; return; }
        grid = cus;
    }
    if (grid < 0) return;
    if (hipMemsetAsync((char*)d_ws + WS_CTL, 0, CTL_ZERO_BYTES, stream) != hipSuccess) { fprintf(stderr, "kernel_launch: memset failed\n"); return; }
    Args a{};
    for (int i = 0; i < 17; ++i) a.in[i] = (const float*)d_in[i];
    a.out = (float*)d_out; a.ws = (unsigned char*)d_ws;
    hipLaunchKernelGGL(mk_fwd, dim3(grid), dim3(NWAVES * 64), LDS_BYTES, stream, a);
}
```
